# Optimizing an MI355X kernel written in HIP

```python
import jax, jax.numpy as jnp
from jax import lax
import numpy as np

D_MODEL = 2048
BATCH = 1
SEQ = 8192
DEPTH = 1

N_HEADS = 8
HEAD_DIM = 128
N_KV = 2
HEADS_PER_KV = N_HEADS // N_KV
CMP_BLOCK = 32
CMP_STRIDE = 16
SEL_BLOCK = 64
N_SELECT = 16
WINDOW = 512
Q_BLOCK = 128
SGU_WIDTH = 1024
SGU_GROUPS = 8
SGU_GROUP_DIM = SGU_WIDTH // SGU_GROUPS
SGU_CHUNK = 128
D_FF = 5504
CONV_WIDTH = 3
NORM_EPS = 1e-6
LN_EPS = 1e-5
NEG_INF = -1e30
FORCE_SCORE = 1e6

Q_W = N_HEADS * HEAD_DIM
KV_W = N_KV * HEAD_DIM
NSA_GATE_W = 3 * N_HEADS
IN_SIZES = (Q_W, KV_W, KV_W, KV_W, KV_W, KV_W, KV_W, NSA_GATE_W, SGU_WIDTH, SGU_WIDTH, D_MODEL, D_MODEL)
IN_W = sum(IN_SIZES)

kernel_name = 'hybrid_nsa_gmlp_convffn_block'


def rms_norm(x, g):
    x32 = x.astype(jnp.float32)
    y = x32 * lax.rsqrt(jnp.mean(x32 * x32, -1, keepdims=True) + NORM_EPS)
    return (y * g.astype(jnp.float32)).astype(x.dtype)


def layer_norm(x, g, b):
    x32 = x.astype(jnp.float32)
    xc = x32 - jnp.mean(x32, -1, keepdims=True)
    y = xc * lax.rsqrt(jnp.mean(xc * xc, -1, keepdims=True) + LN_EPS)
    return (y * g.astype(jnp.float32) + b.astype(jnp.float32)).astype(x.dtype)


def masked_softmax(s, mask):
    p = jax.nn.softmax(jnp.where(mask, s, NEG_INF), axis=-1)
    return p * jnp.any(mask, -1, keepdims=True)


def alibi_slopes():
    return jnp.exp2(-8.0 * jnp.arange(1, N_HEADS + 1, dtype=jnp.float32) / N_HEADS)


def compress(kv, pe, w1, w2):
    B, T = kv.shape[:2]
    n_cmp = (T - CMP_BLOCK) // CMP_STRIDE + 1
    idx = jnp.arange(n_cmp)[:, None] * CMP_STRIDE + jnp.arange(CMP_BLOCK)[None, :]
    blocks = kv[:, idx] + pe[:, None, :]
    blocks = blocks.transpose(0, 3, 1, 2, 4).reshape(B, N_KV, n_cmp, CMP_BLOCK * HEAD_DIM)
    return jax.nn.gelu(blocks @ w1) @ w2


def nsa_attention(q, k_cmp, v_cmp, k_slc, v_slc, k_win, v_win, gates,
                  cmp_k_pe, cmp_k_w1, cmp_k_w2, cmp_v_pe, cmp_v_w1, cmp_v_w2):
    B, T = q.shape[:2]
    kc = compress(k_cmp, cmp_k_pe, cmp_k_w1, cmp_k_w2)
    vc = compress(v_cmp, cmp_v_pe, cmp_v_w1, cmp_v_w2)
    n_cmp = kc.shape[2]
    n_sel = T // SEL_BLOCK
    top_n = min(N_SELECT, n_sel)
    cmp_start = jnp.arange(n_cmp) * CMP_STRIDE
    cmp_end = cmp_start + CMP_BLOCK - 1
    sel_start = jnp.arange(n_sel) * SEL_BLOCK
    sel_end = sel_start + SEL_BLOCK - 1
    overlap = jnp.clip(jnp.minimum(cmp_end[:, None], sel_end[None]) - jnp.maximum(cmp_start[:, None], sel_start[None]) + 1, 0).astype(jnp.float32)
    ks = k_slc.reshape(B, n_sel, SEL_BLOCK, N_KV, HEAD_DIM).transpose(0, 3, 1, 2, 4)
    vs = v_slc.reshape(B, n_sel, SEL_BLOCK, N_KV, HEAD_DIM).transpose(0, 3, 1, 2, 4)
    pad = ((0, 0), (0, 0), (WINDOW, 0), (0, 0))
    kw = jnp.pad(k_win.transpose(0, 2, 1, 3), pad)
    vw = jnp.pad(v_win.transpose(0, 2, 1, 3), pad)
    n_qb = T // Q_BLOCK
    qb = q.reshape(B, n_qb, Q_BLOCK, N_KV, HEADS_PER_KV, HEAD_DIM).transpose(1, 0, 3, 4, 2, 5)
    slopes = alibi_slopes().reshape(N_KV, HEADS_PER_KV)[:, :, None, None]
    scale = HEAD_DIM ** -0.5
    b_ix = jnp.arange(B)[:, None, None, None]
    g_ix = jnp.arange(N_KV)[None, :, None, None]
    j_sel = jnp.arange(n_sel)

    def block_fn(args):
        qblk, i = args
        t = i * Q_BLOCK + jnp.arange(Q_BLOCK)
        qf = qblk * scale
        dist = (t[:, None] - cmp_end[None]).astype(jnp.float32)
        s = jnp.einsum('bghqd,bgnd->bghqn', qf, kc).astype(jnp.float32) - slopes * dist
        p_cmp = masked_softmax(s, dist >= 0)
        o_cmp = jnp.einsum('bghqn,bgnd->bghqd', p_cmp.astype(vc.dtype), vc)
        imp = jnp.einsum('bghqn,nj->bgqj', p_cmp, overlap)
        cur = t[:, None] // SEL_BLOCK
        valid = sel_start[None] <= t[:, None]
        forced = (j_sel[None] == 0) | (j_sel[None] == cur) | (j_sel[None] == cur - 1)
        imp = jnp.where(forced, FORCE_SCORE, jnp.where(valid, imp, NEG_INF))
        _, sel = lax.top_k(imp, top_n)
        kg = ks[b_ix, g_ix, sel].reshape(B, N_KV, Q_BLOCK, top_n * SEL_BLOCK, HEAD_DIM)
        vg = vs[b_ix, g_ix, sel].reshape(B, N_KV, Q_BLOCK, top_n * SEL_BLOCK, HEAD_DIM)
        pos = (sel[..., None] * SEL_BLOCK + jnp.arange(SEL_BLOCK)).reshape(B, N_KV, Q_BLOCK, top_n * SEL_BLOCK)
        dist = (t[:, None] - pos).astype(jnp.float32)[:, :, None]
        s = jnp.einsum('bghqd,bgqkd->bghqk', qf, kg).astype(jnp.float32) - slopes * dist
        p = masked_softmax(s, dist >= 0)
        o_slc = jnp.einsum('bghqk,bgqkd->bghqd', p.astype(vg.dtype), vg)
        kwb = lax.dynamic_slice_in_dim(kw, i * Q_BLOCK, WINDOW + Q_BLOCK, axis=2)
        vwb = lax.dynamic_slice_in_dim(vw, i * Q_BLOCK, WINDOW + Q_BLOCK, axis=2)
        spos = i * Q_BLOCK - WINDOW + jnp.arange(WINDOW + Q_BLOCK)
        d_int = t[:, None] - spos[None]
        mask = (d_int >= 0) & (d_int < WINDOW) & (spos[None] >= 0)
        s = jnp.einsum('bghqd,bgkd->bghqk', qf, kwb).astype(jnp.float32) - slopes * d_int.astype(jnp.float32)
        p = masked_softmax(s, mask)
        o_win = jnp.einsum('bghqk,bgkd->bghqd', p.astype(vwb.dtype), vwb)
        return o_cmp, o_slc, o_win

    o_cmp, o_slc, o_win = lax.map(block_fn, (qb, jnp.arange(n_qb)))
    to_bthd = lambda o: o.transpose(1, 0, 4, 2, 3, 5).reshape(B, T, N_HEADS, HEAD_DIM)
    g = jax.nn.sigmoid(gates)
    o = g[..., 0:1] * to_bthd(o_cmp) + g[..., 1:2] * to_bthd(o_slc) + g[..., 2:3] * to_bthd(o_win)
    return o.reshape(B, T, Q_W)


def spatial_gating(u, v, ln_g, ln_b, w_s, b_s):
    B, T, _ = u.shape
    v = layer_norm(v, ln_g, ln_b)
    n_chunk = T // SGU_CHUNK
    v = v.reshape(B, n_chunk, SGU_CHUNK, SGU_GROUPS, SGU_GROUP_DIM)
    causal = jnp.tril(jnp.ones((SGU_CHUNK, SGU_CHUNK), dtype=bool))
    w = jnp.where(causal, w_s, 0)
    s = jnp.einsum('gts,bnsgd->bntgd', w, v) + b_s.T[None, None, :, :, None]
    return u * s.reshape(B, T, SGU_WIDTH)


def causal_dwconv(a, w, b):
    y = lax.conv_general_dilated(a, w[:, None, :], window_strides=(1,), padding=[(CONV_WIDTH - 1, 0)],
                                 dimension_numbers=('NWC', 'WIO', 'NWC'), feature_group_count=a.shape[-1])
    return y + b


def hybrid_layer(x, norm1_g, w_in, cmp_k_pe, cmp_k_w1, cmp_k_w2, cmp_v_pe, cmp_v_w1, cmp_v_w2,
                 sgu_ln_g, sgu_ln_b, sgu_w, sgu_b, w_branch_a, w_branch_b, w_out,
                 norm2_g, ffn_w_in, ffn_conv_w, ffn_conv_b, ffn_w_down):
    B, T, _ = x.shape
    offsets = np.cumsum(IN_SIZES)[:-1].tolist()
    h = rms_norm(x, norm1_g)
    (q, k_cmp, v_cmp, k_slc, v_slc, k_win, v_win, nsa_g, sgu_u, sgu_v, gate_a, gate_b) = jnp.split(h @ w_in, offsets, axis=-1)
    kvh = lambda t: t.reshape(B, T, N_KV, HEAD_DIM)
    y_a = nsa_attention(q.reshape(B, T, N_HEADS, HEAD_DIM), kvh(k_cmp), kvh(v_cmp), kvh(k_slc), kvh(v_slc),
                        kvh(k_win), kvh(v_win), nsa_g.reshape(B, T, N_HEADS, 3),
                        cmp_k_pe, cmp_k_w1, cmp_k_w2, cmp_v_pe, cmp_v_w1, cmp_v_w2)
    y_b = spatial_gating(jax.nn.gelu(sgu_u), jax.nn.gelu(sgu_v), sgu_ln_g, sgu_ln_b, sgu_w, sgu_b)
    mixed = jax.nn.sigmoid(gate_a) * (y_a @ w_branch_a) + jax.nn.sigmoid(gate_b) * (y_b @ w_branch_b)
    x = x + mixed @ w_out
    h2 = rms_norm(x, norm2_g)
    a, b = jnp.split(h2 @ ffn_w_in, 2, axis=-1)
    return x + (jax.nn.gelu(causal_dwconv(a, ffn_conv_w, ffn_conv_b)) * b) @ ffn_w_down


def setup_inputs(seed: int = 0) -> dict:
    key = jax.random.key(seed)
    ks = jax.random.split(key, 24)
    f32 = jnp.float32
    L = DEPTH
    nrm = lambda k, shape, s: jax.random.normal(k, shape, f32) * s
    return {
        'x': nrm(ks[0], (BATCH, SEQ, D_MODEL), 1.0),
        'norm1_g': 1.0 + nrm(ks[1], (L, D_MODEL), 0.02),
        'w_in': nrm(ks[2], (L, D_MODEL, IN_W), D_MODEL ** -0.5),
        'cmp_k_pe': nrm(ks[3], (L, CMP_BLOCK, HEAD_DIM), 0.1),
        'cmp_k_w1': nrm(ks[4], (L, CMP_BLOCK * HEAD_DIM, HEAD_DIM), (CMP_BLOCK * HEAD_DIM) ** -0.5),
        'cmp_k_w2': nrm(ks[5], (L, HEAD_DIM, HEAD_DIM), HEAD_DIM ** -0.5),
        'cmp_v_pe': nrm(ks[6], (L, CMP_BLOCK, HEAD_DIM), 0.1),
        'cmp_v_w1': nrm(ks[7], (L, CMP_BLOCK * HEAD_DIM, HEAD_DIM), (CMP_BLOCK * HEAD_DIM) ** -0.5),
        'cmp_v_w2': nrm(ks[8], (L, HEAD_DIM, HEAD_DIM), HEAD_DIM ** -0.5),
        'sgu_ln_g': 1.0 + nrm(ks[9], (L, SGU_WIDTH), 0.02),
        'sgu_ln_b': nrm(ks[10], (L, SGU_WIDTH), 0.02),
        'sgu_w': nrm(ks[11], (L, SGU_GROUPS, SGU_CHUNK, SGU_CHUNK), SGU_CHUNK ** -0.5),
        'sgu_b': 1.0 + nrm(ks[12], (L, SGU_GROUPS, SGU_CHUNK), 0.02),
        'w_branch_a': nrm(ks[13], (L, Q_W, D_MODEL), Q_W ** -0.5),
        'w_branch_b': nrm(ks[14], (L, SGU_WIDTH, D_MODEL), SGU_WIDTH ** -0.5),
        'w_out': nrm(ks[15], (L, D_MODEL, D_MODEL), D_MODEL ** -0.5),
        'norm2_g': 1.0 + nrm(ks[16], (L, D_MODEL), 0.02),
        'ffn_w_in': nrm(ks[17], (L, D_MODEL, 2 * D_FF), D_MODEL ** -0.5),
        'ffn_conv_w': nrm(ks[18], (L, CONV_WIDTH, D_FF), CONV_WIDTH ** -0.5),
        'ffn_conv_b': nrm(ks[19], (L, D_FF), 0.02),
        'ffn_w_down': nrm(ks[20], (L, D_FF, D_MODEL), D_FF ** -0.5),
        'final_g': 1.0 + nrm(ks[21], (D_MODEL,), 0.02),
    }


def reference(x, norm1_g, w_in, cmp_k_pe, cmp_k_w1, cmp_k_w2, cmp_v_pe, cmp_v_w1, cmp_v_w2,
              sgu_ln_g, sgu_ln_b, sgu_w, sgu_b, w_branch_a, w_branch_b, w_out,
              norm2_g, ffn_w_in, ffn_conv_w, ffn_conv_b, ffn_w_down, final_g):
    for l in range(DEPTH):
        x = hybrid_layer(x, norm1_g[l], w_in[l], cmp_k_pe[l], cmp_k_w1[l], cmp_k_w2[l],
                         cmp_v_pe[l], cmp_v_w1[l], cmp_v_w2[l], sgu_ln_g[l], sgu_ln_b[l],
                         sgu_w[l], sgu_b[l], w_branch_a[l], w_branch_b[l], w_out[l],
                         norm2_g[l], ffn_w_in[l], ffn_conv_w[l], ffn_conv_b[l], ffn_w_down[l])
    return rms_norm(x, final_g)
```

```cpp
#include <hip/hip_runtime.h>
#include <hip/hip_cooperative_groups.h>
#include <cstdio>
#include <cstdint>
namespace cg = cooperative_groups;

#ifndef MK_ONE_LAUNCH
#define MK_ONE_LAUNCH 0
#endif

namespace pg8 {
#define PG8_LAS __attribute__((address_space(3)))
typedef unsigned short bf16_t;
typedef short bf16x8 __attribute__((ext_vector_type(8)));
typedef float f32x4 __attribute__((ext_vector_type(4)));
typedef unsigned u32x4 __attribute__((ext_vector_type(4)));
typedef unsigned u32x2 __attribute__((ext_vector_type(2)));
constexpr int BM = 256, BK = 64, HALF = 128, HTB = HALF * BK * 2, STAGE_BYTES = 8 * HTB, NXCD = 8, WGM = 8;

__host__ __device__ __forceinline__ int lds_byte(int r, int c) { const int st = (r >> 4) * 2 + (c >> 5), rr = r & 15, cc = c & 31, ob = rr * 64 + cc * 2; return st * 1024 + (ob ^ (((ob >> 9) & 1) << 5)); }
__host__ __device__ __forceinline__ void stage_rc(int b, int& R, int& C) { const int st = b / 1024, sb = b % 1024, swz = sb ^ (((sb >> 9) & 1) << 5); R = (st >> 1) * 16 + swz / 64; C = (st & 1) * 32 + (swz % 64) / 2; }
__host__ __device__ __forceinline__ int perm32(int rho) { const int n = rho >> 4, i = rho & 15; return 8 * (i >> 2) + 4 * n + (i & 3); }

struct Unit { int pm, pn; };
struct Gemm { const bf16_t* A; const bf16_t* Bt; int M, N, K; };

struct StaticOrder {
    int nM, nN, nwg, G, c;
    __host__ __device__ void init(int M, int N, int G_, int c_) { nM = M / BM; nN = N / BM; nwg = nM * nN; G = G_; c = c_; }
    __host__ __device__ bool next(int i, Unit& u) const {
        const long L = (long)i * G + c; if (L >= nwg) return false;
        int wgid = (int)L; { const int q = nwg / NXCD, r = nwg % NXCD, xcd = wgid % NXCD, off = wgid / NXCD; wgid = (xcd < r ? xcd * (q + 1) : r * (q + 1) + (xcd - r) * q) + off; }
        const int nig = WGM * nN, gid = wgid / nig, fm = gid * WGM, gsz = (nM - fm) < WGM ? (nM - fm) : WGM;
        u.pm = fm + ((wgid % nig) % gsz); u.pn = (wgid % nig) / gsz; return true;
    }
    __device__ __forceinline__ void a_ready(const Unit&) const {}
    __device__ __forceinline__ void done(const Unit&) const {}
};

__device__ __forceinline__ unsigned cvt_pk_bf16(float lo, float hi) { unsigned r; asm volatile("v_cvt_pk_bf16_f32 %0, %1, %2" : "=v"(r) : "v"(lo), "v"(hi)); return r; }

template <class Epi, class Sched, bool ALIGN_EPI = false, bool SP2 = false>
__device__ __forceinline__ void gemm_phase(PG8_LAS unsigned char* lds, const Gemm g, const Sched& S, const Epi& E) {
    const int tid = threadIdx.x, wid = __builtin_amdgcn_readfirstlane(tid >> 6), lane = tid & 63, wr = wid >> 2, wc = wid & 3, fr = lane & 15, fq = lane >> 4;
    const int K = g.K, nt = K / BK;
    unsigned voffA[2], voffB[2];
#pragma unroll
    for (int i = 0; i < 2; ++i) { int R, C; stage_rc(tid * 16 + i * 8192, R, C); const int Rb = Epi::PERM ? ((R & ~31) + perm32(R & 31)) : R;
        voffA[i] = (unsigned)(R * K + C) * 2u; voffB[i] = (unsigned)(Rb * K + C) * 2u; }
    const size_t kstep = (size_t)(BK * 2);
    const size_t hstep = (size_t)HALF * K * 2;
    const size_t tstep = 2 * hstep;
    const unsigned ldsw = (unsigned)wid * 1024u;
    const int aoff = lds_byte(wr * 64 + fr, fq * 8), boff = lds_byte(wc * 32 + fr, fq * 8);
#define PG8_SA(b, h) (((b) * 2 + (h)) * HTB)
#define PG8_SB(b, h) ((4 + (b) * 2 + (h)) * HTB)
#define PG8_STAGE(bufoff, gbase, voff) do { _Pragma("unroll") for (int _i = 0; _i < 2; ++_i) \
        __builtin_amdgcn_global_load_lds((const unsigned*)((const char*)(gbase) + (voff)[_i]), (PG8_LAS unsigned*)(lds + (bufoff) + ldsw + _i * 8192), 16, 0, 0); } while (0)
#define PG8_LDA(dst, b, h) do { _Pragma("unroll") for (int m = 0; m < 4; ++m) _Pragma("unroll") for (int k = 0; k < 2; ++k) dst[m][k] = *(const PG8_LAS bf16x8*)(lds + PG8_SA(b, h) + aoff + m * 2048 + k * 1024); } while (0)
#define PG8_LDB(dst, b, h) do { _Pragma("unroll") for (int n = 0; n < 2; ++n) _Pragma("unroll") for (int k = 0; k < 2; ++k) dst[n][k] = *(const PG8_LAS bf16x8*)(lds + PG8_SB(b, h) + boff + n * 2048 + k * 1024); } while (0)
#define PG8_MMA(ai, bj, At, Bt) do { __builtin_amdgcn_s_setprio(1); _Pragma("unroll") for (int m = 0; m < 4; ++m) _Pragma("unroll") for (int n = 0; n < 2; ++n) _Pragma("unroll") for (int k = 0; k < 2; ++k) \
        acc[ai][bj][m][n] = __builtin_amdgcn_mfma_f32_16x16x32_bf16(Bt[n][k], At[m][k], acc[ai][bj][m][n], 0, 0, 0); __builtin_amdgcn_s_setprio(0); } while (0)
#define PG8_WAIT_V(n) asm volatile("s_waitcnt vmcnt(" #n ")" ::: "memory")
#define PG8_WAIT_L(n) asm volatile("s_waitcnt lgkmcnt(" #n ")" ::: "memory")
#define PG8_BAR __builtin_amdgcn_s_barrier()
#define PG8_SCHED __builtin_amdgcn_sched_barrier(0)
    Unit cur, nxt; int ui = 0;
    if (!S.next(0, cur)) return;
    f32x4 acc[2][2][4][2];
#pragma unroll
    for (int a = 0; a < 2; ++a)
#pragma unroll
        for (int b = 0; b < 2; ++b)
#pragma unroll
            for (int m = 0; m < 4; ++m)
#pragma unroll
                for (int n = 0; n < 2; ++n) acc[a][b][m][n] = (f32x4){0.f, 0.f, 0.f, 0.f};
    bf16x8 At[4][2], B0[2][2], B1[2][2];
    const char* cA = (const char*)g.A + (size_t)cur.pm * tstep; const char* cB = (const char*)g.Bt + (size_t)cur.pn * tstep;
    S.a_ready(cur);
    if constexpr (SP2) {
        PG8_STAGE(PG8_SB(0, 0), cB, voffB); PG8_STAGE(PG8_SB(0, 1), cB + hstep, voffB); PG8_STAGE(PG8_SA(0, 0), cA, voffA); PG8_STAGE(PG8_SA(0, 1), cA + hstep, voffA);
        if (wr == 1) PG8_BAR;
        PG8_WAIT_V(2); PG8_BAR;
        PG8_STAGE(PG8_SB(1, 0), cB + kstep, voffB); PG8_STAGE(PG8_SA(1, 0), cA + kstep, voffA); PG8_STAGE(PG8_SB(1, 1), cB + hstep + kstep, voffB);
        PG8_WAIT_V(6); PG8_BAR;
    } else {
        PG8_STAGE(PG8_SB(0, 0), cB, voffB); PG8_STAGE(PG8_SA(0, 0), cA, voffA); PG8_STAGE(PG8_SB(0, 1), cB + hstep, voffB); PG8_STAGE(PG8_SA(0, 1), cA + hstep, voffA);
        if (wr == 1) PG8_BAR;
        PG8_WAIT_V(4); PG8_BAR;
        PG8_STAGE(PG8_SB(1, 0), cB + kstep, voffB); PG8_STAGE(PG8_SA(1, 0), cA + kstep, voffA); PG8_STAGE(PG8_SB(1, 1), cB + hstep + kstep, voffB);
        PG8_WAIT_V(6); PG8_BAR;
    }
    for (;;) {
        const bool has_next = S.next(ui + 1, nxt);
        const char* nA = has_next ? (const char*)g.A + (size_t)nxt.pm * tstep : cA; const char* nB = has_next ? (const char*)g.Bt + (size_t)nxt.pn * tstep : cB;
        for (int t = 0; t < nt; t += 2) {
            const bool last = (t == nt - 2);
            const char* a1 = cA + (size_t)(t + 1) * kstep;
            const char* a2 = last ? nA : cA + (size_t)(t + 2) * kstep; const char* b2 = last ? nB : cB + (size_t)(t + 2) * kstep;
            const char* a3 = a2 + kstep; const char* b3 = b2 + kstep;
            if (last && has_next) S.a_ready(nxt);
            if constexpr (SP2) {
            PG8_LDB(B0, 0, 0); PG8_LDB(B1, 0, 1); PG8_SCHED; PG8_LDA(At, 0, 0); PG8_STAGE(PG8_SA(1, 1), a1 + hstep, voffA);
            PG8_WAIT_V(8); PG8_WAIT_L(0); PG8_BAR; PG8_MMA(0, 0, At, B0); PG8_MMA(0, 1, At, B1); PG8_BAR; PG8_SCHED;
            PG8_LDA(At, 0, 1); PG8_STAGE(PG8_SB(0, 0), b2, voffB); PG8_STAGE(PG8_SB(0, 1), b2 + hstep, voffB); PG8_STAGE(PG8_SA(0, 0), a2, voffA);
            PG8_WAIT_V(8); PG8_WAIT_L(0); PG8_BAR; PG8_MMA(1, 0, At, B0); PG8_MMA(1, 1, At, B1); PG8_BAR; PG8_SCHED;
            PG8_LDB(B0, 1, 0); PG8_LDB(B1, 1, 1); PG8_SCHED; PG8_LDA(At, 1, 0); PG8_STAGE(PG8_SA(0, 1), a2 + hstep, voffA);
            PG8_WAIT_V(8); PG8_WAIT_L(0); PG8_BAR; PG8_MMA(0, 0, At, B0); PG8_MMA(0, 1, At, B1); PG8_BAR; PG8_SCHED;
            PG8_LDA(At, 1, 1); PG8_STAGE(PG8_SB(1, 0), b3, voffB); PG8_STAGE(PG8_SB(1, 1), b3 + hstep, voffB); PG8_STAGE(PG8_SA(1, 0), a3, voffA);
            PG8_WAIT_V(8); PG8_WAIT_L(0); PG8_BAR; PG8_MMA(1, 0, At, B0); PG8_MMA(1, 1, At, B1); PG8_BAR; PG8_SCHED;
            } else {
            PG8_LDB(B0, 0, 0); PG8_SCHED; PG8_LDA(At, 0, 0); PG8_STAGE(PG8_SA(1, 1), a1 + hstep, voffA);
            PG8_WAIT_L(8); PG8_BAR; PG8_WAIT_L(0); PG8_MMA(0, 0, At, B0); PG8_BAR; PG8_SCHED;
            PG8_LDB(B1, 0, 1); PG8_STAGE(PG8_SB(0, 0), b2, voffB);
            PG8_BAR; PG8_WAIT_L(0); PG8_MMA(0, 1, At, B1); PG8_BAR;
            PG8_LDA(At, 0, 1); PG8_STAGE(PG8_SA(0, 0), a2, voffA);
            PG8_BAR; PG8_WAIT_L(0); PG8_MMA(1, 0, At, B0); PG8_BAR; PG8_SCHED;
            PG8_STAGE(PG8_SB(0, 1), b2 + hstep, voffB);
            PG8_WAIT_V(6); PG8_BAR; PG8_MMA(1, 1, At, B1); PG8_BAR;
            PG8_LDB(B0, 1, 0); PG8_SCHED; PG8_LDA(At, 1, 0); PG8_STAGE(PG8_SA(0, 1), a2 + hstep, voffA);
            PG8_WAIT_L(8); PG8_BAR; PG8_WAIT_L(0); PG8_MMA(0, 0, At, B0); PG8_BAR; PG8_SCHED;
            PG8_LDB(B1, 1, 1); PG8_STAGE(PG8_SB(1, 0), b3, voffB);
            PG8_BAR; PG8_WAIT_L(0); PG8_MMA(0, 1, At, B1); PG8_BAR;
            PG8_LDA(At, 1, 1); PG8_STAGE(PG8_SA(1, 0), a3, voffA);
            PG8_BAR; PG8_WAIT_L(0); PG8_MMA(1, 0, At, B0); PG8_BAR; PG8_SCHED;
            PG8_STAGE(PG8_SB(1, 1), b3 + hstep, voffB);
            PG8_WAIT_V(6); PG8_BAR; PG8_MMA(1, 1, At, B1); PG8_BAR;
            }
        }
        if constexpr (ALIGN_EPI) { if (wr == 0) PG8_BAR; }
        E(acc, cur, wr, wc, fr, fq); S.done(cur);
        if (!has_next) break;
#pragma unroll
        for (int a = 0; a < 2; ++a)
#pragma unroll
            for (int b = 0; b < 2; ++b)
#pragma unroll
                for (int m = 0; m < 4; ++m)
#pragma unroll
                    for (int n = 0; n < 2; ++n) acc[a][b][m][n] = (f32x4){0.f, 0.f, 0.f, 0.f};
        cur = nxt; cA = nA; cB = nB; ++ui;
        if constexpr (ALIGN_EPI) { if (wr == 1) PG8_BAR; }
    }
    PG8_WAIT_V(0);
    if constexpr (!ALIGN_EPI) { if (wr == 0) PG8_BAR; }
    PG8_BAR;
#undef PG8_SA
#undef PG8_SB
#undef PG8_STAGE
#undef PG8_LDA
#undef PG8_LDB
#undef PG8_MMA
#undef PG8_WAIT_V
#undef PG8_WAIT_L
#undef PG8_BAR
#undef PG8_SCHED
}
}

typedef unsigned short bf16;
typedef float f32x4 __attribute__((ext_vector_type(4)));
typedef unsigned u32x4 __attribute__((ext_vector_type(4)));
typedef unsigned u32x2 __attribute__((ext_vector_type(2)));
constexpr int T = 8192, DM = 2048, NH = 8, HD = 128, NKV = 2, QW = 1024, KVW = 256, SGW = 1024, DFF = 5504;
constexpr int INW = 8728, NP0 = 8960;
constexpr int NWAVES = 8, NTHR = 512;
constexpr float NORM_EPS = 1e-6f, LN_EPS = 1e-5f;
constexpr float QSCALE = 0.08838834764831845f;

constexpr size_t MiB = 1u << 20;
constexpr size_t WS_WFFN = 0;
constexpr size_t WS_WDOWN = 43 * MiB;
constexpr size_t WS_H = WS_WDOWN + 43 * MiB / 2;
constexpr size_t WS_O = WS_H + 32 * MiB;
constexpr size_t WS_WIN = WS_O;
constexpr size_t WS_Q = WS_WIN + 35 * MiB;
constexpr size_t WS_KV = WS_Q + 16 * MiB;
constexpr size_t WS_U = WS_KV + 24 * MiB;
constexpr size_t WS_V = WS_U + 16 * MiB;
constexpr size_t WS_GA = WS_V + 16 * MiB;
constexpr size_t WS_GB = WS_GA + 32 * MiB;
constexpr size_t WS_NSAG = WS_GB + 32 * MiB;
constexpr size_t WS_A = WS_O;
constexpr size_t WS_B = WS_A + 86 * MiB;
constexpr size_t WS_MIXED = WS_Q;
constexpr size_t WS_TA = WS_U;
constexpr size_t WS_YA = WS_O + 172 * MiB;
constexpr size_t WS_YB = WS_YA + 16 * MiB;
constexpr size_t WS_WOUT = WS_YB + 16 * MiB;
constexpr size_t WS_WPA = WS_WOUT + 8 * MiB;
constexpr size_t WS_WPB = WS_WPA + 4 * MiB;
constexpr size_t WS_KC = WS_WPB + 4 * MiB;
constexpr size_t WS_P2 = WS_KC + 1 * MiB;
constexpr size_t WS_P3 = WS_P2 + 1 * MiB;
constexpr size_t WS_END = WS_P3 + 1 * MiB;
static_assert(WS_NSAG + (size_t)T * 24 * 4 <= WS_O + 172 * MiB && WS_B + 86 * MiB == WS_O + 172 * MiB, "overlay map");

constexpr int LDS_BYTES = 147456;

__device__ __forceinline__ float bf2f(unsigned short b) { return __uint_as_float(((unsigned)b) << 16); }
__device__ __forceinline__ float bflo(unsigned w) { return __uint_as_float(w << 16); }
__device__ __forceinline__ float bfhi(unsigned w) { return __uint_as_float(w & 0xffff0000u); }
__device__ __forceinline__ unsigned f2bf(float f) { unsigned u = __float_as_uint(f); return (u + 0x7fffu + ((u >> 16) & 1u)) >> 16; }
__device__ __forceinline__ unsigned pk2(float lo, float hi) { return pg8::cvt_pk_bf16(lo, hi); }
__device__ __forceinline__ float gelu_t(float x) {
    const float u = 1.5957691216057308f * (x + 0.044715f * x * x * x);
    return x / (1.0f + __expf(-u));
}
__device__ __forceinline__ float sigmoid_f(float x) { return 1.0f / (1.0f + __expf(-x)); }
__device__ __forceinline__ float wave_sum(float v) {
#pragma unroll
    for (int o = 1; o < 64; o <<= 1) v += __shfl_xor(v, o);
    return v;
}
__device__ __forceinline__ float wave_max(float v) {
#pragma unroll
    for (int o = 1; o < 64; o <<= 1) v = fmaxf(v, __shfl_xor(v, o));
    return v;
}

struct Args {
    const float* in[22];
    float* out;
    unsigned char* ws;
    int ph_lo, ph_hi;
};

using pg8::Unit;
struct Epi0 {
    static constexpr bool PERM = false, AFTER_DRAIN = false;
    unsigned char* ws;
    template <int ACT> __device__ __forceinline__ void store(const f32x4 (&acc)[2][2][4][2], bf16* base, int ldc, int colbase, const Unit& u, int wr, int wc, int fr, int fq) const {
        const int row0 = u.pm * 256 + wr * 64 + fr, col0 = colbase + wc * 32 + 4 * fq;
#pragma unroll
        for (int ai = 0; ai < 2; ++ai)
#pragma unroll
            for (int m = 0; m < 4; ++m) { bf16* rowp = base + (size_t)(row0 + ai * 128 + m * 16) * ldc + col0;
#pragma unroll
                for (int bj = 0; bj < 2; ++bj)
#pragma unroll
                    for (int n = 0; n < 2; ++n) { f32x4 v = acc[ai][bj][m][n];
                        if (ACT == 0) { v = v * QSCALE; }
                        if (ACT == 2) { v[0] = gelu_t(v[0]); v[1] = gelu_t(v[1]); v[2] = gelu_t(v[2]); v[3] = gelu_t(v[3]); }
                        if (ACT == 3) { v[0] = sigmoid_f(v[0]); v[1] = sigmoid_f(v[1]); v[2] = sigmoid_f(v[2]); v[3] = sigmoid_f(v[3]); }
                        u32x2 w; w.x = pk2(v[0], v[1]); w.y = pk2(v[2], v[3]);
                        *(u32x2*)(rowp + bj * 128 + n * 16) = w; } }
    }
    __device__ __forceinline__ void operator()(const f32x4 (&acc)[2][2][4][2], const Unit& u, int wr, int wc, int fr, int fq) const {
        const int pn = u.pn;
        if (pn < 4) store<0>(acc, (bf16*)(ws + WS_Q), 1024, pn * 256, u, wr, wc, fr, fq);
        else if (pn < 10) store<1>(acc, (bf16*)(ws + WS_KV) + (size_t)(pn - 4) * T * 256, 256, 0, u, wr, wc, fr, fq);
        else if (pn < 14) store<2>(acc, (bf16*)(ws + WS_U), 1024, (pn - 10) * 256, u, wr, wc, fr, fq);
        else if (pn < 18) store<2>(acc, (bf16*)(ws + WS_V), 1024, (pn - 14) * 256, u, wr, wc, fr, fq);
        else if (pn < 26) store<3>(acc, (bf16*)(ws + WS_GA), 2048, (pn - 18) * 256, u, wr, wc, fr, fq);
        else if (pn < 34) store<3>(acc, (bf16*)(ws + WS_GB), 2048, (pn - 26) * 256, u, wr, wc, fr, fq);
        else {
            float* ng = (float*)(ws + WS_NSAG);
            if (wc == 0) {
                const int row0 = u.pm * 256 + wr * 64 + fr;
#pragma unroll
                for (int ai = 0; ai < 2; ++ai)
#pragma unroll
                    for (int m = 0; m < 4; ++m)
#pragma unroll
                        for (int n = 0; n < 2; ++n) { const int c = 16 * n + 4 * fq;
                            if (c < 24) { f32x4 v = acc[ai][0][m][n]; f32x4 o; o[0] = sigmoid_f(v[0]); o[1] = sigmoid_f(v[1]); o[2] = sigmoid_f(v[2]); o[3] = sigmoid_f(v[3]);
                                *(f32x4*)(ng + (size_t)(row0 + ai * 128 + m * 16) * 24 + c) = o; } }
            }
        }
    }
};
struct EpiP4a {
    static constexpr bool PERM = false, AFTER_DRAIN = false;
    const bf16* gate; bf16* out;
    __device__ __forceinline__ void operator()(const f32x4 (&acc)[2][2][4][2], const Unit& u, int wr, int wc, int fr, int fq) const {
        const int row0 = u.pm * 256 + wr * 64 + fr, col0 = u.pn * 256 + wc * 32 + 4 * fq;
#pragma unroll
        for (int ai = 0; ai < 2; ++ai)
#pragma unroll
            for (int m = 0; m < 4; ++m) { const size_t ro = (size_t)(row0 + ai * 128 + m * 16) * 2048 + col0;
#pragma unroll
                for (int bj = 0; bj < 2; ++bj)
#pragma unroll
                    for (int n = 0; n < 2; ++n) { const f32x4 v = acc[ai][bj][m][n]; const size_t o = ro + bj * 128 + n * 16;
                        const u32x2 gw = *(const u32x2*)(gate + o);
                        u32x2 w; w.x = pk2(v[0] * bflo(gw.x), v[1] * bfhi(gw.x)); w.y = pk2(v[2] * bflo(gw.y), v[3] * bfhi(gw.y));
                        *(u32x2*)(out + o) = w; } }
    }
};
struct EpiP4b {
    static constexpr bool PERM = false, AFTER_DRAIN = false;
    const bf16* gate; const bf16* ta; bf16* out;
    __device__ __forceinline__ void operator()(const f32x4 (&acc)[2][2][4][2], const Unit& u, int wr, int wc, int fr, int fq) const {
        const int row0 = u.pm * 256 + wr * 64 + fr, col0 = u.pn * 256 + wc * 32 + 4 * fq;
#pragma unroll
        for (int ai = 0; ai < 2; ++ai)
#pragma unroll
            for (int m = 0; m < 4; ++m) { const size_t ro = (size_t)(row0 + ai * 128 + m * 16) * 2048 + col0;
#pragma unroll
                for (int bj = 0; bj < 2; ++bj)
#pragma unroll
                    for (int n = 0; n < 2; ++n) { const f32x4 v = acc[ai][bj][m][n]; const size_t o = ro + bj * 128 + n * 16;
                        const u32x2 gw = *(const u32x2*)(gate + o); const u32x2 tw = *(const u32x2*)(ta + o);
                        u32x2 w; w.x = pk2(bflo(tw.x) + v[0] * bflo(gw.x), bfhi(tw.x) + v[1] * bfhi(gw.x)); w.y = pk2(bflo(tw.y) + v[2] * bflo(gw.y), bfhi(tw.y) + v[3] * bfhi(gw.y));
                        *(u32x2*)(out + o) = w; } }
    }
};
struct EpiRes {
    static constexpr bool PERM = false, AFTER_DRAIN = false;
    const float* xi; float* xo; bf16* xb; float* part;
    __device__ __forceinline__ void operator()(const f32x4 (&acc)[2][2][4][2], const Unit& u, int wr, int wc, int fr, int fq) const {
        const int row0 = u.pm * 256 + wr * 64 + fr, col0 = u.pn * 256 + wc * 32 + 4 * fq;
#pragma unroll
        for (int ai = 0; ai < 2; ++ai)
#pragma unroll
            for (int m = 0; m < 4; ++m) { const int row = row0 + ai * 128 + m * 16; const size_t ro = (size_t)row * 2048 + col0; float ss = 0.f;
#pragma unroll
                for (int bj = 0; bj < 2; ++bj)
#pragma unroll
                    for (int n = 0; n < 2; ++n) { const size_t o = ro + bj * 128 + n * 16;
                        const f32x4 v = acc[ai][bj][m][n] + *(const f32x4*)(xi + o);
                        *(f32x4*)(xo + o) = v; ss += (v[0] * v[0] + v[1] * v[1]) + (v[2] * v[2] + v[3] * v[3]);
                        if (xb) { u32x2 w; w.x = pk2(v[0], v[1]); w.y = pk2(v[2], v[3]); *(u32x2*)(xb + o) = w; } }
                ss += __shfl_xor(ss, 16); ss += __shfl_xor(ss, 32);
                if (fq == 0) part[(size_t)row * 32 + u.pn * 4 + wc] = ss; }
    }
};
struct EpiFfnIn {
    static constexpr bool PERM = false, AFTER_DRAIN = false;
    const float* part; bf16* a; bf16* b;
    __device__ __forceinline__ void operator()(const f32x4 (&acc)[2][2][4][2], const Unit& u, int wr, int wc, int fr, int fq) const {
        const int row0 = u.pm * 256 + wr * 64 + fr;
#pragma unroll
        for (int ai = 0; ai < 2; ++ai)
#pragma unroll
            for (int m = 0; m < 4; ++m) { const int row = row0 + ai * 128 + m * 16;
                const f32x4 p0 = *(const f32x4*)(part + (size_t)row * 32 + fq * 8), p1 = *(const f32x4*)(part + (size_t)row * 32 + fq * 8 + 4);
                float ss = ((p0[0] + p0[1]) + (p0[2] + p0[3])) + ((p1[0] + p1[1]) + (p1[2] + p1[3]));
                ss += __shfl_xor(ss, 16); ss += __shfl_xor(ss, 32);
                const float r = rsqrtf(ss * (1.0f / 2048.0f) + NORM_EPS);
#pragma unroll
                for (int bj = 0; bj < 2; ++bj) { const int cg0 = u.pn * 256 + bj * 128; bf16* base = cg0 < DFF ? a + cg0 : b + (cg0 - DFF);
#pragma unroll
                    for (int n = 0; n < 2; ++n) { const f32x4 v = acc[ai][bj][m][n] * r;
                        u32x2 w; w.x = pk2(v[0], v[1]); w.y = pk2(v[2], v[3]);
                        *(u32x2*)(base + (size_t)row * DFF + wc * 32 + n * 16 + 4 * fq) = w; } } }
    }
};

struct Frame {
    unsigned char* lds;
    int tid, lane, wave, G, bid;
    unsigned char* ws;
};

__device__ __forceinline__ void transpose_item(const float* W, int ldw, int c0, int nvalid, const float* gain, bf16* WT, int ldk, int r0, int nblk, float* scr, int item, int lane) {
    const int kb = item / nblk, nb = item % nblk, k0 = 64 * kb, n0 = 32 * nb;
    const int nn = lane & 31; const bool ok = (n0 + nn) < nvalid;
#pragma unroll 8
    for (int i = 0; i < 32; ++i) { const int kk = 2 * i + (lane >> 5);
        float v = ok ? W[(size_t)(k0 + kk) * ldw + c0 + n0 + nn] : 0.f; if (gain) v *= gain[k0 + kk];
        scr[kk * 33 + nn] = v; }
    __builtin_amdgcn_s_waitcnt(0xc07f); asm volatile("" ::: "memory");
    const int c = lane & 7;
#pragma unroll
    for (int j = 0; j < 4; ++j) { const int n = (lane >> 3) + 8 * j; const float* s = scr + (8 * c) * 33 + n;
        u32x4 o; o.x = pk2(s[0 * 33], s[1 * 33]); o.y = pk2(s[2 * 33], s[3 * 33]); o.z = pk2(s[4 * 33], s[5 * 33]); o.w = pk2(s[6 * 33], s[7 * 33]);
        *(u32x4*)(WT + (size_t)(r0 + n0 + n) * ldk + k0 + 8 * c) = o; }
    __builtin_amdgcn_s_waitcnt(0xc07f); asm volatile("" ::: "memory");
}
__device__ __forceinline__ void p0_prologue(const Frame& F, const Args& A) {
    float* scr = (float*)(F.lds + F.wave * 16384);
    const int gw = F.bid * NWAVES + F.wave, NGW = F.G * NWAVES;
    unsigned char* ws = F.ws;
    constexpr int I_IN1 = 32 * (2560 / 32), I_IN2 = 32 * (6144 / 32), I_IN3 = 32 * (256 / 32);
    constexpr int I_FFN = 32 * (11008 / 32), I_DOWN = (DFF / 64) * (2048 / 32), I_OUT = 32 * (2048 / 32), I_PA = 16 * (2048 / 32);
    constexpr int NITEMS = I_IN1 + I_IN2 + I_IN3 + I_FFN + I_DOWN + I_OUT + 2 * I_PA;
    for (int it = gw; it < NITEMS; it += NGW) {
        int r = it;
        if (r < I_IN1) { transpose_item(A.in[2], INW, 0, 2560, A.in[1], (bf16*)(ws + WS_WIN), 2048, 0, 2560 / 32, scr, r, F.lane); continue; } r -= I_IN1;
        if (r < I_IN2) { transpose_item(A.in[2], INW, 2584, 6144, A.in[1], (bf16*)(ws + WS_WIN), 2048, 2560, 6144 / 32, scr, r, F.lane); continue; } r -= I_IN2;
        if (r < I_IN3) { transpose_item(A.in[2], INW, 2560, 24, A.in[1], (bf16*)(ws + WS_WIN), 2048, 8704, 256 / 32, scr, r, F.lane); continue; } r -= I_IN3;
        if (r < I_FFN) { transpose_item(A.in[17], 2 * DFF, 0, 2 * DFF, A.in[16], (bf16*)(ws + WS_WFFN), 2048, 0, 11008 / 32, scr, r, F.lane); continue; } r -= I_FFN;
        if (r < I_DOWN) { transpose_item(A.in[20], 2048, 0, 2048, nullptr, (bf16*)(ws + WS_WDOWN), DFF, 0, 2048 / 32, scr, r, F.lane); continue; } r -= I_DOWN;
        if (r < I_OUT) { transpose_item(A.in[15], 2048, 0, 2048, nullptr, (bf16*)(ws + WS_WOUT), 2048, 0, 2048 / 32, scr, r, F.lane); continue; } r -= I_OUT;
        if (r < I_PA) { transpose_item(A.in[13], 2048, 0, 2048, nullptr, (bf16*)(ws + WS_WPA), 1024, 0, 2048 / 32, scr, r, F.lane); continue; } r -= I_PA;
        transpose_item(A.in[14], 2048, 0, 2048, nullptr, (bf16*)(ws + WS_WPB), 1024, 0, 2048 / 32, scr, r, F.lane);
    }
    const float* x = A.in[0]; bf16* h = (bf16*)(ws + WS_H);
    for (int m = gw; m < T; m += NGW) {
        const f32x4* xr = (const f32x4*)(x + (size_t)m * DM) + F.lane;
        f32x4 v[8]; float s = 0.f;
#pragma unroll
        for (int j = 0; j < 8; ++j) { v[j] = xr[64 * j]; s += (v[j][0] * v[j][0] + v[j][1] * v[j][1]) + (v[j][2] * v[j][2] + v[j][3] * v[j][3]); }
        const float r = rsqrtf(wave_sum(s) * (1.0f / DM) + NORM_EPS);
        u32x2* o = (u32x2*)(h + (size_t)m * DM) + F.lane;
#pragma unroll
        for (int j = 0; j < 8; ++j) { u32x2 w; w.x = pk2(v[j][0] * r, v[j][1] * r); w.y = pk2(v[j][2] * r, v[j][3] * r); o[64 * j] = w; }
    }
}

__device__ __forceinline__ void p2_compress(const Frame& F, const Args& A) {
    float* inb = (float*)F.lds;
    float* hid = inb + 4 * 4096;
    const int sub = F.tid >> 7, j = F.tid & 127;
    for (int item = F.bid; item < 512; item += F.G) {
        const int kvsel = item >> 8, g = (item >> 7) & 1, n = (item & 127) * 4 + sub;
        const bf16* src = (const bf16*)(F.ws + WS_KV) + (size_t)kvsel * T * 256;
        const float* pe = A.in[kvsel ? 6 : 3]; const float* w1 = A.in[kvsel ? 7 : 4]; const float* w2 = A.in[kvsel ? 8 : 5];
        __syncthreads();
        if (n < 511) {
            for (int e = j; e < 4096; e += 128) { const int l = e >> 7, d = e & 127; inb[sub * 4096 + e] = bf2f(src[(size_t)(16 * n + l) * 256 + g * 128 + d]) + pe[e]; }
        }
        __syncthreads();
        float acc = 0.f;
        if (n < 511) {
            const float* ib = inb + sub * 4096;
#pragma unroll 8
            for (int k = 0; k < 4096; ++k) acc += ib[k] * w1[(size_t)k * 128 + j];
            acc = gelu_t(acc);
        }
        hid[sub * 128 + j] = acc;
        __syncthreads();
        float o = 0.f;
        if (n < 511) {
#pragma unroll 8
            for (int k = 0; k < 128; ++k) o += hid[sub * 128 + k] * w2[k * 128 + j];
        }
        bf16* dst = (bf16*)(F.ws + WS_KC) + (size_t)kvsel * 2 * 512 * 128 + ((size_t)g * 512 + n) * 128;
        dst[j] = (bf16)f2bf(o);
    }
    __syncthreads();
}

__device__ __forceinline__ void p2_sgu(const Frame& F, const Args& A) {
    float* vt = (float*)F.lds;
    float* wt = vt + 128 * 128;
    float* st = wt + 128 * 128;
    const bf16* gu = (const bf16*)(F.ws + WS_U); const bf16* gv = (const bf16*)(F.ws + WS_V); bf16* yb = (bf16*)(F.ws + WS_YB);
    const float* ln_g = A.in[9]; const float* ln_b = A.in[10]; const float* sw = A.in[11]; const float* sb = A.in[12];
    for (int item = F.bid; item < 512; item += F.G) {
        const int c = item >> 3, g = item & 7;
        __syncthreads();
        for (int i = 0; i < 16; ++i) { const int s = F.wave * 16 + i; const bf16* row = gv + (size_t)(c * 128 + s) * SGW;
            float xv[16]; float sum = 0.f;
            const u32x4 w0 = *(const u32x4*)(row + F.lane * 8), w1 = *(const u32x4*)(row + 512 + F.lane * 8);
            xv[0] = bflo(w0.x); xv[1] = bfhi(w0.x); xv[2] = bflo(w0.y); xv[3] = bfhi(w0.y); xv[4] = bflo(w0.z); xv[5] = bfhi(w0.z); xv[6] = bflo(w0.w); xv[7] = bfhi(w0.w);
            xv[8] = bflo(w1.x); xv[9] = bfhi(w1.x); xv[10] = bflo(w1.y); xv[11] = bfhi(w1.y); xv[12] = bflo(w1.z); xv[13] = bfhi(w1.z); xv[14] = bflo(w1.w); xv[15] = bfhi(w1.w);
#pragma unroll
            for (int k = 0; k < 16; ++k) sum += xv[k];
            const float mean = wave_sum(sum) * (1.0f / SGW); float sq = 0.f;
#pragma unroll
            for (int k = 0; k < 16; ++k) { const float d = xv[k] - mean; sq += d * d; }
            const float rstd = rsqrtf(wave_sum(sq) * (1.0f / SGW) + LN_EPS);
            if (F.lane == 0) { st[2 * s] = mean; st[2 * s + 1] = rstd; } }
        __syncthreads();
        for (int e = F.tid; e < 128 * 128; e += NTHR) { const int s = e >> 7, d = e & 127;
            vt[e] = (bf2f(gv[(size_t)(c * 128 + s) * SGW + g * 128 + d]) - st[2 * s]) * st[2 * s + 1] * ln_g[g * 128 + d] + ln_b[g * 128 + d];
            const int t = e >> 7, s2 = e & 127; wt[e] = (s2 <= t) ? sw[(size_t)g * 128 * 128 + e] : 0.f; }
        __syncthreads();
        const int tq = F.tid >> 7, d = F.tid & 127;
        for (int ti = 0; ti < 32; ++ti) { const int t = tq + 4 * ti; float acc = 0.f;
            for (int s = 0; s <= t; ++s) acc += wt[t * 128 + s] * vt[s * 128 + d];
            const size_t o = (size_t)(c * 128 + t) * SGW + g * 128 + d;
            yb[o] = (bf16)f2bf((acc + sb[g * 128 + t]) * bf2f(gu[o])); }
    }
    __syncthreads();
}

__device__ __forceinline__ void softmax_row(float* s, int n, int lane) {
    float m = -3.0e38f;
    for (int i = lane; i < n; i += 64) m = fmaxf(m, s[i]);
    m = wave_max(m);
    if (m <= -1.0e29f) { for (int i = lane; i < n; i += 64) s[i] = 0.f; return; }
    float l = 0.f;
    for (int i = lane; i < n; i += 64) { const float v = s[i]; const float p = v > -1.0e29f ? __expf(v - m) : 0.f; s[i] = p; l += p; }
    l = wave_sum(l); const float inv = 1.0f / l;
    for (int i = lane; i < n; i += 64) s[i] *= inv;
}
__device__ __forceinline__ void dot4_row(const bf16* krow, const float* qs, float (&d)[4]) {
    d[0] = d[1] = d[2] = d[3] = 0.f;
#pragma unroll 4
    for (int c = 0; c < 16; ++c) { const u32x4 w = *(const u32x4*)(krow + c * 8); float kv[8];
        kv[0] = bflo(w.x); kv[1] = bfhi(w.x); kv[2] = bflo(w.y); kv[3] = bfhi(w.y); kv[4] = bflo(w.z); kv[5] = bfhi(w.z); kv[6] = bflo(w.w); kv[7] = bfhi(w.w);
#pragma unroll
        for (int e = 0; e < 8; ++e) {
#pragma unroll
            for (int h = 0; h < 4; ++h) d[h] += kv[e] * qs[h * 128 + c * 8 + e]; } }
}
__device__ __forceinline__ void p3_attn_naive(const Frame& F, const Args& A) {
    float* qs = (float*)F.lds;
    float* sc = qs + 512;
    float* impv = sc + 4096;
    int* sel = (int*)(impv + 128);
    const bf16* qb = (const bf16*)(F.ws + WS_Q); const bf16* kvb = (const bf16*)(F.ws + WS_KV);
    const bf16* kcb = (const bf16*)(F.ws + WS_KC); const float* ng = (const float*)(F.ws + WS_NSAG); bf16* ya = (bf16*)(F.ws + WS_YA);
    const int hh = F.tid >> 7, d = F.tid & 127;
    for (int item = F.bid; item < T * NKV; item += F.G) {
        const int t = item >> 1, g = item & 1, h = 4 * g + hh;
        const float slope_mine = exp2f(-(float)(h + 1));
        __syncthreads();
        qs[F.tid] = bf2f(qb[(size_t)t * QW + h * 128 + d]);
        __syncthreads();
        float yfin = 0.f;
        const float g0 = ng[(size_t)t * 24 + h * 3 + 0], g1 = ng[(size_t)t * 24 + h * 3 + 1], g2 = ng[(size_t)t * 24 + h * 3 + 2];
        const int nv = t >= 31 ? ((t - 31) >> 4) + 1 : 0;
        const bf16* kc = kcb + (size_t)g * 512 * 128; const bf16* vc = kcb + (size_t)2 * 512 * 128 + (size_t)g * 512 * 128;
        {
            const int n = F.tid;
            if (n < nv) { float dd[4]; dot4_row(kc + (size_t)n * 128, qs, dd); const float dist = (float)(t - (16 * n + 31));
#pragma unroll
                for (int q = 0; q < 4; ++q) sc[q * 1024 + n] = dd[q] - exp2f(-(float)(4 * g + q + 1)) * dist; }
        }
        __syncthreads();
        if (F.wave < 4) softmax_row(sc + F.wave * 1024, nv, F.lane);
        __syncthreads();
        {
            float o = 0.f;
            for (int n = 0; n < nv; ++n) o += sc[hh * 1024 + n] * bf2f(vc[(size_t)n * 128 + d]);
            yfin += g0 * o;
        }
        if (F.tid < 128) {
            const int j = F.tid; float imp = 0.f;
            for (int n = 4 * j - 1; n <= 4 * j + 3; ++n) if (n >= 0 && n < nv) {
                const int lo = max(16 * n, 64 * j), hi = min(16 * n + 31, 64 * j + 63); const float ov = (float)max(hi - lo + 1, 0);
                imp += (sc[n] + sc[1024 + n] + sc[2048 + n] + sc[3072 + n]) * ov; }
            const int cur = t >> 6; const bool forced = (j == 0) || (j == cur) || (j == cur - 1);
            impv[j] = forced ? 1.0e6f : ((64 * j <= t) ? imp : -1.0e30f);
        }
        __syncthreads();
        if (F.wave == 0) {
            float v0 = impv[F.lane], v1 = impv[F.lane + 64];
            for (int r = 0; r < 16; ++r) {
                float bv = v1 > v0 ? v1 : v0; int bi = v1 > v0 ? F.lane + 64 : F.lane;
#pragma unroll
                for (int o = 32; o >= 1; o >>= 1) { const float ov = __shfl_xor(bv, o); const int oi = __shfl_xor(bi, o); if (ov > bv || (ov == bv && oi < bi)) { bv = ov; bi = oi; } }
                if (bi == F.lane) v0 = -3.0e38f; if (bi == F.lane + 64) v1 = -3.0e38f;
                if (F.lane == 0) sel[r] = bi;
            }
        }
        __syncthreads();
        {
            const bf16* ks = kvb + (size_t)2 * T * 256;
            for (int idx = F.tid; idx < 1024; idx += NTHR) { const int pos = sel[idx >> 6] * 64 + (idx & 63);
                if (pos <= t) { float dd[4]; dot4_row(ks + (size_t)pos * 256 + g * 128, qs, dd); const float dist = (float)(t - pos);
#pragma unroll
                    for (int q = 0; q < 4; ++q) sc[q * 1024 + idx] = dd[q] - exp2f(-(float)(4 * g + q + 1)) * dist; }
                else {
#pragma unroll
                    for (int q = 0; q < 4; ++q) sc[q * 1024 + idx] = -1.0e30f; } }
        }
        __syncthreads();
        if (F.wave < 4) softmax_row(sc + F.wave * 1024, 1024, F.lane);
        __syncthreads();
        {
            const bf16* vs = kvb + (size_t)3 * T * 256; float o = 0.f;
            for (int b = 0; b < 16; ++b) { const int p0 = sel[b] * 64; if (p0 > t) continue;
                for (int kk = 0; kk < 64; ++kk) { const float p = sc[hh * 1024 + b * 64 + kk]; o += p * bf2f(vs[(size_t)(p0 + kk) * 256 + g * 128 + d]); } }
            yfin += g1 * o;
        }
        __syncthreads();
        {
            const bf16* kw = kvb + (size_t)4 * T * 256;
            const int idx = F.tid, pos = t - 511 + idx;
            if (pos >= 0) { float dd[4]; dot4_row(kw + (size_t)pos * 256 + g * 128, qs, dd); const float dist = (float)(t - pos);
#pragma unroll
                for (int q = 0; q < 4; ++q) sc[q * 1024 + idx] = dd[q] - exp2f(-(float)(4 * g + q + 1)) * dist; }
            else {
#pragma unroll
                for (int q = 0; q < 4; ++q) sc[q * 1024 + idx] = -1.0e30f; }
        }
        __syncthreads();
        if (F.wave < 4) softmax_row(sc + F.wave * 1024, 512, F.lane);
        __syncthreads();
        {
            const bf16* vw = kvb + (size_t)5 * T * 256; float o = 0.f;
            const int i0 = t >= 511 ? 0 : 511 - t;
            for (int idx = i0; idx < 512; ++idx) o += sc[hh * 1024 + idx] * bf2f(vw[(size_t)(t - 511 + idx) * 256 + g * 128 + d]);
            yfin += g2 * o;
        }
        ya[(size_t)t * QW + h * 128 + d] = (bf16)f2bf(yfin);
        (void)slope_mine;
    }
    __syncthreads();
}

__device__ __forceinline__ void p6_conv(const Frame& F, const Args& A) {
    const bf16* a = (const bf16*)(F.ws + WS_A); bf16* b = (bf16*)(F.ws + WS_B);
    const float* cw = A.in[18]; const float* cb = A.in[19];
    constexpr int CH = DFF / 8;
    const long total = (long)T * CH;
    for (long e = (long)F.bid * NTHR + F.tid; e < total; e += (long)F.G * NTHR) {
        const int t = (int)(e / CH), j0 = (int)(e % CH) * 8;
        const u32x4 z = {0u, 0u, 0u, 0u};
        const u32x4 a2 = *(const u32x4*)(a + (size_t)t * DFF + j0);
        const u32x4 a1 = t >= 1 ? *(const u32x4*)(a + (size_t)(t - 1) * DFF + j0) : z;
        const u32x4 a0 = t >= 2 ? *(const u32x4*)(a + (size_t)(t - 2) * DFF + j0) : z;
        const u32x4 bb = *(const u32x4*)(b + (size_t)t * DFF + j0);
        float o[8];
#pragma unroll
        for (int k = 0; k < 8; ++k) {
            const unsigned w0 = a0[k >> 1], w1 = a1[k >> 1], w2 = a2[k >> 1], wb = bb[k >> 1];
            const float x0 = (k & 1) ? bfhi(w0) : bflo(w0), x1 = (k & 1) ? bfhi(w1) : bflo(w1), x2 = (k & 1) ? bfhi(w2) : bflo(w2), xb = (k & 1) ? bfhi(wb) : bflo(wb);
            const float y = cw[j0 + k] * x0 + cw[DFF + j0 + k] * x1 + cw[2 * DFF + j0 + k] * x2 + cb[j0 + k];
            o[k] = gelu_t(y) * xb; }
        u32x4 w; w.x = pk2(o[0], o[1]); w.y = pk2(o[2], o[3]); w.z = pk2(o[4], o[5]); w.w = pk2(o[6], o[7]);
        *(u32x4*)(b + (size_t)t * DFF + j0) = w;
    }
}

__device__ __forceinline__ void p8_final(const Frame& F, const Args& A) {
    const int gw = F.bid * NWAVES + F.wave, NGW = F.G * NWAVES;
    const float* part = (const float*)(F.ws + WS_P3); const float* fg = A.in[21];
    for (int m = gw; m < T; m += NGW) {
        float s = F.lane < 32 ? part[(size_t)m * 32 + F.lane] : 0.f;
        const float r = rsqrtf(wave_sum(s) * (1.0f / DM) + NORM_EPS);
        f32x4* xr = (f32x4*)(A.out + (size_t)m * DM) + F.lane; const f32x4* gr = (const f32x4*)fg + F.lane;
#pragma unroll
        for (int j = 0; j < 8; ++j) { const f32x4 v = xr[64 * j], gg = gr[64 * j]; xr[64 * j] = v * r * gg; }
    }
}

constexpr int NPHASE = 12;
__global__ void __launch_bounds__(NTHR, 2) mega_fwd(Args args) {
    extern __shared__ __attribute__((aligned(16))) unsigned char lds[];
    cg::grid_group grid = cg::this_grid();
    Frame F; F.lds = lds; F.tid = threadIdx.x; F.lane = F.tid & 63; F.wave = __builtin_amdgcn_readfirstlane(F.tid >> 6); F.G = gridDim.x; F.bid = blockIdx.x; F.ws = args.ws;
    PG8_LAS unsigned char* lds3 = (PG8_LAS unsigned char*)lds;
    const int lo = args.ph_lo, hi = args.ph_hi;
#define IN(k) (lo <= (k) && (k) < hi)
#define SEAM(k) do { if (IN(k) && IN((k) + 1)) grid.sync(); } while (0)
    unsigned char* ws = args.ws;
    if (IN(0)) { p0_prologue(F, args); } SEAM(0);
    if (IN(1)) {
        pg8::Gemm g{(const bf16*)(ws + WS_H), (const bf16*)(ws + WS_WIN), T, NP0, DM}; pg8::StaticOrder S; S.init(T, NP0, F.G, F.bid);
        Epi0 E{ws}; pg8::gemm_phase<Epi0, pg8::StaticOrder, true, true>(lds3, g, S, E);
    } SEAM(1);
    if (IN(2)) { p2_compress(F, args); p2_sgu(F, args); } SEAM(2);
    if (IN(3)) { p3_attn_naive(F, args); } SEAM(3);
    if (IN(4)) {
        pg8::Gemm g{(const bf16*)(ws + WS_YA), (const bf16*)(ws + WS_WPA), T, DM, QW}; pg8::StaticOrder S; S.init(T, DM, F.G, F.bid);
        EpiP4a E{(const bf16*)(ws + WS_GA), (bf16*)(ws + WS_TA)}; pg8::gemm_phase<EpiP4a, pg8::StaticOrder, true, true>(lds3, g, S, E);
    } SEAM(4);
    if (IN(5)) {
        pg8::Gemm g{(const bf16*)(ws + WS_YB), (const bf16*)(ws + WS_WPB), T, DM, SGW}; pg8::StaticOrder S; S.init(T, DM, F.G, F.bid);
        EpiP4b E{(const bf16*)(ws + WS_GB), (const bf16*)(ws + WS_TA), (bf16*)(ws + WS_MIXED)}; pg8::gemm_phase<EpiP4b, pg8::StaticOrder, true, true>(lds3, g, S, E);
    } SEAM(5);
    if (IN(6)) {
        pg8::Gemm g{(const bf16*)(ws + WS_MIXED), (const bf16*)(ws + WS_WOUT), T, DM, DM}; pg8::StaticOrder S; S.init(T, DM, F.G, F.bid);
        EpiRes E{args.in[0], args.out, (bf16*)(ws + WS_H), (float*)(ws + WS_P2)}; pg8::gemm_phase<EpiRes, pg8::StaticOrder, true, true>(lds3, g, S, E);
    } SEAM(6);
    if (IN(7)) {
        pg8::Gemm g{(const bf16*)(ws + WS_H), (const bf16*)(ws + WS_WFFN), T, 2 * DFF, DM}; pg8::StaticOrder S; S.init(T, 2 * DFF, F.G, F.bid);
        EpiFfnIn E{(const float*)(ws + WS_P2), (bf16*)(ws + WS_A), (bf16*)(ws + WS_B)}; pg8::gemm_phase<EpiFfnIn, pg8::StaticOrder, true, true>(lds3, g, S, E);
    } SEAM(7);
    if (IN(8)) { p6_conv(F, args); } SEAM(8);
    if (IN(9)) {
        pg8::Gemm g{(const bf16*)(ws + WS_B), (const bf16*)(ws + WS_WDOWN), T, DM, DFF}; pg8::StaticOrder S; S.init(T, DM, F.G, F.bid);
        EpiRes E{args.out, args.out, nullptr, (float*)(ws + WS_P3)}; pg8::gemm_phase<EpiRes, pg8::StaticOrder, true, true>(lds3, g, S, E);
    } SEAM(9);
    if (IN(10)) { p8_final(F, args); }
#undef IN
#undef SEAM
}

extern "C" void kernel_launch(void* const* d_in, const int* in_sizes, int n_in, void* d_out, int out_size, void* d_ws, size_t ws_size, hipStream_t stream) {
    static int grid = 0;
    if (grid == 0) {
        if (n_in != 22 || in_sizes[0] != T * DM || out_size != T * DM || ws_size < WS_END) {
            fprintf(stderr, "kernel_launch: unexpected problem (n_in %d, in0 %d, out %d, ws %zu, need %zu)\n", n_in, n_in > 0 ? in_sizes[0] : -1, out_size, ws_size, (size_t)WS_END); grid = -1; return; }
        int dev = 0, cus = 0, per_cu = 0;
        hipGetDevice(&dev); hipDeviceGetAttribute(&cus, hipDeviceAttributeMultiprocessorCount, dev);
        hipFuncSetAttribute((const void*)mega_fwd, hipFuncAttributeMaxDynamicSharedMemorySize, LDS_BYTES);
        hipOccupancyMaxActiveBlocksPerMultiprocessor(&per_cu, (const void*)mega_fwd, NTHR, LDS_BYTES);
        (void)hipGetLastError();
        if (per_cu < 1) { fprintf(stderr, "kernel_launch: occupancy query says %d blocks per CU\n", per_cu); grid = -1; return; }
        grid = cus;
    }
    if (grid < 0) return;
    Args a{};
    for (int i = 0; i < 22; ++i) a.in[i] = (const float*)d_in[i];
    a.out = (float*)d_out; a.ws = (unsigned char*)d_ws;
#if MK_ONE_LAUNCH
    a.ph_lo = 0; a.ph_hi = NPHASE;
    void* kargs[] = {&a};
    hipError_t e = hipLaunchCooperativeKernel((const void*)mega_fwd, dim3(grid), dim3(NTHR), kargs, LDS_BYTES, stream);
    if (e != hipSuccess) fprintf(stderr, "cooperative launch failed: %s (grid %d)\n", hipGetErrorString(e), grid);
#else
    for (int p = 0; p <= 10; ++p) {
        a.ph_lo = p; a.ph_hi = p + 1;
        hipLaunchKernelGGL(mega_fwd, dim3(grid), dim3(NTHR), LDS_BYTES, stream, a);
    }
#endif
}
```

```cpp
#include <hip/hip_runtime.h>
#include <hip/hip_cooperative_groups.h>
#include <cstdio>
#include <cstdint>
namespace cg = cooperative_groups;

#ifndef MK_ONE_LAUNCH
#define MK_ONE_LAUNCH 1
#endif
#ifndef DBL_PHASE
#define DBL_PHASE -1
#endif
#ifndef FILL_FFN_IN_P1
#define FILL_FFN_IN_P1 0
#endif
#ifndef FILL_DOWN_IN_P6
#define FILL_DOWN_IN_P6 1
#endif
#ifndef ATT_DBL
#define ATT_DBL 0
#endif
#ifndef GSYNC_SEAM
#define GSYNC_SEAM -1
#endif
#ifndef WGM_BIG
#define WGM_BIG 4
#endif
#ifndef WGM_MIX
#define WGM_MIX 4
#endif

namespace pg8 {
#define PG8_LAS __attribute__((address_space(3)))
typedef unsigned short bf16_t;
typedef short bf16x8 __attribute__((ext_vector_type(8)));
typedef float f32x4 __attribute__((ext_vector_type(4)));
typedef unsigned u32x4 __attribute__((ext_vector_type(4)));
typedef unsigned u32x2 __attribute__((ext_vector_type(2)));
constexpr int BM = 256, BK = 64, HALF = 128, HTB = HALF * BK * 2, STAGE_BYTES = 8 * HTB, NXCD = 8, WGM = 8;

__host__ __device__ __forceinline__ int lds_byte(int r, int c) { const int st = (r >> 4) * 2 + (c >> 5), rr = r & 15, cc = c & 31, ob = rr * 64 + cc * 2; return st * 1024 + (ob ^ (((ob >> 9) & 1) << 5)); }
__host__ __device__ __forceinline__ void stage_rc(int b, int& R, int& C) { const int st = b / 1024, sb = b % 1024, swz = sb ^ (((sb >> 9) & 1) << 5); R = (st >> 1) * 16 + swz / 64; C = (st & 1) * 32 + (swz % 64) / 2; }
__host__ __device__ __forceinline__ int perm32(int rho) { const int n = rho >> 4, i = rho & 15; return 8 * (i >> 2) + 4 * n + (i & 3); }

struct Unit { int pm, pn, kh; };
struct Gemm { const bf16_t* A; const bf16_t* Bt; int M, N, K, ld; size_t ksa = 0, ksb = 0; };

struct StaticOrder {
    int nM, nN, nwg, G, c, wgm = WGM;
    __host__ __device__ void init(int M, int N, int G_, int c_) { nM = M / BM; nN = N / BM; nwg = nM * nN; G = G_; c = c_; }
    __host__ __device__ bool next(int i, Unit& u) const {
        const long L = (long)i * G + c; if (L >= nwg) return false;
        int wgid = (int)L; { const int q = nwg / NXCD, r = nwg % NXCD, xcd = wgid % NXCD, off = wgid / NXCD; wgid = (xcd < r ? xcd * (q + 1) : r * (q + 1) + (xcd - r) * q) + off; }
        const int nig = wgm * nN, gid = wgid / nig, fm = gid * wgm, gsz = (nM - fm) < wgm ? (nM - fm) : wgm;
        u.pm = fm + ((wgid % nig) % gsz); u.pn = (wgid % nig) / gsz; u.kh = 0; return true;
    }
    __device__ __forceinline__ void a_ready(const Unit&) const {}
    __device__ __forceinline__ void done(const Unit&) const {}
    __host__ __device__ __forceinline__ int arow(int pm) const { return pm * BM; }
    __host__ __device__ __forceinline__ int amap(int R) const { return R; }
    __host__ __device__ __forceinline__ int ahrows() const { return HALF; }
};
struct MixOrder : StaticOrder {
    __host__ __device__ bool next(int i, Unit& u) const { if (!StaticOrder::next(i >> 1, u)) return false; u.kh = i & 1; return true; }
};
struct FfnOrder : StaticOrder {
    __host__ __device__ void init_tiles(int nM_, int nN_, int G_, int c_) { nM = nM_; nN = nN_; nwg = nM * nN; G = G_; c = c_; }
    __host__ __device__ __forceinline__ int arow(int pm) const { return 248 * pm - 2; }
    __host__ __device__ __forceinline__ int amap(int R) const { return R - 2 * (R >> 6); }
    __host__ __device__ __forceinline__ int ahrows() const { return 124; }
};

typedef float f32x2_cv __attribute__((ext_vector_type(2))); typedef __bf16 bf16x2_cv __attribute__((ext_vector_type(2)));
__device__ __forceinline__ unsigned cvt_pk_bf16(float lo, float hi) { const f32x2_cv v = {lo, hi}; const bf16x2_cv b = __builtin_convertvector(v, bf16x2_cv); return __builtin_bit_cast(unsigned, b); }

template <class Epi, class Sched, bool ALIGN_EPI = false, bool SP2 = false>
__device__ __forceinline__ void gemm_phase(PG8_LAS unsigned char* lds, const Gemm g, const Sched& S, const Epi& E) {
    const int tid = threadIdx.x, wid = __builtin_amdgcn_readfirstlane(tid >> 6), lane = tid & 63, wr = wid >> 2, wc = wid & 3, fr = lane & 15, fq = lane >> 4;
    const int K = g.K, nt = K / BK;
    unsigned voffA[2], voffB[2];
#pragma unroll
    for (int i = 0; i < 2; ++i) { int R, C; stage_rc(tid * 16 + i * 8192, R, C); const int Rb = Epi::PERM ? ((R & ~31) + perm32(R & 31)) : R;
        voffA[i] = (unsigned)(S.amap(R) * g.ld + C) * 2u; voffB[i] = (unsigned)(Rb * g.ld + C) * 2u; }
    const size_t kstepA = g.ksa ? g.ksa : (size_t)(BK * 2), kstepB = g.ksb ? g.ksb : (size_t)(BK * 2);
    const size_t hstep = (size_t)HALF * g.ld * 2, hstepA = (size_t)S.ahrows() * g.ld * 2;
    const size_t tstep = 2 * hstep;
    const unsigned ldsw = (unsigned)wid * 1024u;
    const int aoff = lds_byte(wr * 64 + fr, fq * 8), boff = lds_byte(wc * 32 + fr, fq * 8);
#define PG8_SA(b, h) (((b) * 2 + (h)) * HTB)
#define PG8_SB(b, h) ((4 + (b) * 2 + (h)) * HTB)
#define PG8_STAGE(bufoff, gbase, voff) do { _Pragma("unroll") for (int _i = 0; _i < 2; ++_i) \
        __builtin_amdgcn_global_load_lds((const unsigned*)((const char*)(gbase) + (voff)[_i]), (PG8_LAS unsigned*)(lds + (bufoff) + ldsw + _i * 8192), 16, 0, 0); } while (0)
#define PG8_LDA(dst, b, h) do { _Pragma("unroll") for (int m = 0; m < 4; ++m) _Pragma("unroll") for (int k = 0; k < 2; ++k) dst[m][k] = *(const PG8_LAS bf16x8*)(lds + PG8_SA(b, h) + aoff + m * 2048 + k * 1024); } while (0)
#define PG8_LDB(dst, b, h) do { _Pragma("unroll") for (int n = 0; n < 2; ++n) _Pragma("unroll") for (int k = 0; k < 2; ++k) dst[n][k] = *(const PG8_LAS bf16x8*)(lds + PG8_SB(b, h) + boff + n * 2048 + k * 1024); } while (0)
#define PG8_MMA(ai, bj, At, Bt) do { __builtin_amdgcn_s_setprio(1); _Pragma("unroll") for (int m = 0; m < 4; ++m) _Pragma("unroll") for (int n = 0; n < 2; ++n) _Pragma("unroll") for (int k = 0; k < 2; ++k) \
        acc[ai][bj][m][n] = __builtin_amdgcn_mfma_f32_16x16x32_bf16(Bt[n][k], At[m][k], acc[ai][bj][m][n], 0, 0, 0); __builtin_amdgcn_s_setprio(0); } while (0)
#define PG8_WAIT_V(n) asm volatile("s_waitcnt vmcnt(" #n ")" ::: "memory")
#define PG8_WAIT_L(n) asm volatile("s_waitcnt lgkmcnt(" #n ")" ::: "memory")
#define PG8_BAR __builtin_amdgcn_s_barrier()
#define PG8_SCHED __builtin_amdgcn_sched_barrier(0)
    Unit cur, nxt; int ui = 0;
    if (!S.next(0, cur)) return;
    f32x4 acc[2][2][4][2];
#pragma unroll
    for (int a = 0; a < 2; ++a)
#pragma unroll
        for (int b = 0; b < 2; ++b)
#pragma unroll
            for (int m = 0; m < 4; ++m)
#pragma unroll
                for (int n = 0; n < 2; ++n) acc[a][b][m][n] = (f32x4){0.f, 0.f, 0.f, 0.f};
    bf16x8 At[4][2], B0[2][2], B1[2][2];
    const size_t rstep = (size_t)g.ld * 2, khstep = (size_t)K * 2;
    const char* cA = (const char*)g.A + (ptrdiff_t)S.arow(cur.pm) * (ptrdiff_t)rstep + cur.kh * khstep; const char* cB = (const char*)g.Bt + (size_t)cur.pn * tstep + cur.kh * khstep;
    S.a_ready(cur);
    if constexpr (SP2) {
        PG8_STAGE(PG8_SB(0, 0), cB, voffB); PG8_STAGE(PG8_SB(0, 1), cB + hstep, voffB); PG8_STAGE(PG8_SA(0, 0), cA, voffA); PG8_STAGE(PG8_SA(0, 1), cA + hstepA, voffA);
        if (wr == 1) PG8_BAR;
        PG8_WAIT_V(2); PG8_BAR;
        PG8_STAGE(PG8_SB(1, 0), cB + kstepB, voffB); PG8_STAGE(PG8_SA(1, 0), cA + kstepA, voffA); PG8_STAGE(PG8_SB(1, 1), cB + hstep + kstepB, voffB);
        PG8_WAIT_V(6); PG8_BAR;
    } else {
        PG8_STAGE(PG8_SB(0, 0), cB, voffB); PG8_STAGE(PG8_SA(0, 0), cA, voffA); PG8_STAGE(PG8_SB(0, 1), cB + hstep, voffB); PG8_STAGE(PG8_SA(0, 1), cA + hstepA, voffA);
        if (wr == 1) PG8_BAR;
        PG8_WAIT_V(4); PG8_BAR;
        PG8_STAGE(PG8_SB(1, 0), cB + kstepB, voffB); PG8_STAGE(PG8_SA(1, 0), cA + kstepA, voffA); PG8_STAGE(PG8_SB(1, 1), cB + hstep + kstepB, voffB);
        PG8_WAIT_V(6); PG8_BAR;
    }
    for (;;) {
        const bool has_next = S.next(ui + 1, nxt);
        const char* nA = has_next ? (const char*)g.A + (ptrdiff_t)S.arow(nxt.pm) * (ptrdiff_t)rstep + nxt.kh * khstep : cA; const char* nB = has_next ? (const char*)g.Bt + (size_t)nxt.pn * tstep + nxt.kh * khstep : cB;
        for (int t = 0; t < nt; t += 2) {
            const bool last = (t == nt - 2);
            const char* a1 = cA + (size_t)(t + 1) * kstepA;
            const char* a2 = last ? nA : cA + (size_t)(t + 2) * kstepA; const char* b2 = last ? nB : cB + (size_t)(t + 2) * kstepB;
            const char* a3 = a2 + kstepA; const char* b3 = b2 + kstepB;
            if (last && has_next) S.a_ready(nxt);
            if constexpr (SP2) {
            PG8_LDB(B0, 0, 0); PG8_LDB(B1, 0, 1); PG8_SCHED; PG8_LDA(At, 0, 0); PG8_STAGE(PG8_SA(1, 1), a1 + hstepA, voffA);
            PG8_WAIT_V(8); PG8_WAIT_L(0); PG8_BAR; PG8_MMA(0, 0, At, B0); PG8_MMA(0, 1, At, B1); PG8_BAR; PG8_SCHED;
            PG8_LDA(At, 0, 1); PG8_STAGE(PG8_SB(0, 0), b2, voffB); PG8_STAGE(PG8_SB(0, 1), b2 + hstep, voffB); PG8_STAGE(PG8_SA(0, 0), a2, voffA);
            PG8_WAIT_V(8); PG8_WAIT_L(0); PG8_BAR; PG8_MMA(1, 0, At, B0); PG8_MMA(1, 1, At, B1); PG8_BAR; PG8_SCHED;
            PG8_LDB(B0, 1, 0); PG8_LDB(B1, 1, 1); PG8_SCHED; PG8_LDA(At, 1, 0); PG8_STAGE(PG8_SA(0, 1), a2 + hstepA, voffA);
            PG8_WAIT_V(8); PG8_WAIT_L(0); PG8_BAR; PG8_MMA(0, 0, At, B0); PG8_MMA(0, 1, At, B1); PG8_BAR; PG8_SCHED;
            PG8_LDA(At, 1, 1); PG8_STAGE(PG8_SB(1, 0), b3, voffB); PG8_STAGE(PG8_SB(1, 1), b3 + hstep, voffB); PG8_STAGE(PG8_SA(1, 0), a3, voffA);
            PG8_WAIT_V(8); PG8_WAIT_L(0); PG8_BAR; PG8_MMA(1, 0, At, B0); PG8_MMA(1, 1, At, B1); PG8_BAR; PG8_SCHED;
            } else {
            PG8_LDB(B0, 0, 0); PG8_SCHED; PG8_LDA(At, 0, 0); PG8_STAGE(PG8_SA(1, 1), a1 + hstepA, voffA);
            PG8_WAIT_L(8); PG8_BAR; PG8_WAIT_L(0); PG8_MMA(0, 0, At, B0); PG8_BAR; PG8_SCHED;
            PG8_LDB(B1, 0, 1); PG8_STAGE(PG8_SB(0, 0), b2, voffB);
            PG8_BAR; PG8_WAIT_L(0); PG8_MMA(0, 1, At, B1); PG8_BAR;
            PG8_LDA(At, 0, 1); PG8_STAGE(PG8_SA(0, 0), a2, voffA);
            PG8_BAR; PG8_WAIT_L(0); PG8_MMA(1, 0, At, B0); PG8_BAR; PG8_SCHED;
            PG8_STAGE(PG8_SB(0, 1), b2 + hstep, voffB);
            PG8_WAIT_V(6); PG8_BAR; PG8_MMA(1, 1, At, B1); PG8_BAR;
            PG8_LDB(B0, 1, 0); PG8_SCHED; PG8_LDA(At, 1, 0); PG8_STAGE(PG8_SA(0, 1), a2 + hstepA, voffA);
            PG8_WAIT_L(8); PG8_BAR; PG8_WAIT_L(0); PG8_MMA(0, 0, At, B0); PG8_BAR; PG8_SCHED;
            PG8_LDB(B1, 1, 1); PG8_STAGE(PG8_SB(1, 0), b3, voffB);
            PG8_BAR; PG8_WAIT_L(0); PG8_MMA(0, 1, At, B1); PG8_BAR;
            PG8_LDA(At, 1, 1); PG8_STAGE(PG8_SA(1, 0), a3, voffA);
            PG8_BAR; PG8_WAIT_L(0); PG8_MMA(1, 0, At, B0); PG8_BAR; PG8_SCHED;
            PG8_STAGE(PG8_SB(1, 1), b3 + hstep, voffB);
            PG8_WAIT_V(6); PG8_BAR; PG8_MMA(1, 1, At, B1); PG8_BAR;
            }
        }
        if constexpr (ALIGN_EPI) { if (wr == 0) PG8_BAR; }
        if constexpr (Epi::USES_LDS) E(acc, cur, wr, wc, fr, fq, lds, S); else E(acc, cur, wr, wc, fr, fq);
        S.done(cur);
        if (!has_next) break;
        if (!(Epi::HAS_MID && cur.kh == 0)) {
#pragma unroll
        for (int a = 0; a < 2; ++a)
#pragma unroll
            for (int b = 0; b < 2; ++b)
#pragma unroll
                for (int m = 0; m < 4; ++m)
#pragma unroll
                    for (int n = 0; n < 2; ++n) acc[a][b][m][n] = (f32x4){0.f, 0.f, 0.f, 0.f};
        }
        cur = nxt; cA = nA; cB = nB; ++ui;
        if constexpr (ALIGN_EPI) { if (wr == 1) PG8_BAR; }
    }
    PG8_WAIT_V(0);
    if constexpr (!ALIGN_EPI) { if (wr == 0) PG8_BAR; }
    PG8_BAR;
#undef PG8_SA
#undef PG8_SB
#undef PG8_STAGE
#undef PG8_LDA
#undef PG8_LDB
#undef PG8_MMA
#undef PG8_WAIT_V
#undef PG8_WAIT_L
#undef PG8_BAR
#undef PG8_SCHED
}
}

typedef unsigned short bf16;
typedef float f32x4 __attribute__((ext_vector_type(4)));
typedef unsigned u32x4 __attribute__((ext_vector_type(4)));
typedef unsigned u32x2 __attribute__((ext_vector_type(2)));
constexpr int T = 8192, DM = 2048, NH = 8, HD = 128, NKV = 2, QW = 1024, KVW = 256, SGW = 1024, DFF = 5504;
constexpr int INW = 8728, NP0 = 8960, NP0M = 8192;
constexpr int NWAVES = 8, NTHR = 512;
constexpr float NORM_EPS = 1e-6f, LN_EPS = 1e-5f;
constexpr float QSCALE = 0.08838834764831845f * 1.4426950408889634f;
constexpr float LOG2E = 1.4426950408889634f, LN2 = 0.6931471805599453f;

constexpr size_t MiB = 1u << 20;
constexpr size_t WS_WFFN = 0;
constexpr size_t WS_WDOWN = 43 * MiB;
constexpr size_t WS_H = WS_WDOWN + 43 * MiB / 2;
constexpr size_t WS_O = WS_H + 32 * MiB;
constexpr size_t WS_WIN = WS_O;
constexpr size_t WS_Q = WS_WIN + 35 * MiB;
constexpr size_t WS_KV = WS_Q + 16 * MiB;
constexpr size_t WS_U = WS_KV + 24 * MiB;
constexpr size_t WS_V = WS_U + 16 * MiB;
constexpr size_t WS_GA = WS_V + 16 * MiB;
constexpr size_t WS_GB = WS_GA + 32 * MiB;
constexpr size_t WS_NSAG = WS_GB + 32 * MiB;
constexpr size_t WS_A = WS_O;
constexpr size_t WS_B = WS_A + 86 * MiB;
constexpr size_t WS_G = WS_A;
constexpr size_t WS_MIXED = WS_Q;
constexpr size_t WS_TA = WS_U;
constexpr size_t WS_YA = WS_O + 172 * MiB;
constexpr size_t WS_YB = WS_YA + 2048;
constexpr int YLD = 2048;
constexpr size_t WS_WOUT = WS_YA + 32 * MiB;
constexpr size_t WS_WPA = WS_WOUT + 8 * MiB;
constexpr size_t WS_WPB = WS_WPA + 2048;
constexpr size_t WS_KC = WS_WPA + 8 * MiB;
constexpr size_t WS_P2 = WS_KC + 1 * MiB;
constexpr size_t WS_P3 = WS_P2 + 1 * MiB;
constexpr size_t WS_BAR = WS_P3 + 1 * MiB;
constexpr size_t WS_W1T = WS_BAR + 1 * MiB;
constexpr size_t WS_W2T = WS_W1T + 2 * MiB;
constexpr size_t WS_VSTAT = WS_W2T + 1 * MiB;
constexpr size_t WS_END = WS_VSTAT + 1 * MiB;
static_assert(WS_NSAG + (size_t)T * 24 * 4 <= WS_O + 172 * MiB && WS_B + 86 * MiB == WS_O + 172 * MiB, "overlay map");

constexpr int LDS_BYTES = 147456;

__device__ __forceinline__ float bf2f(unsigned short b) { return __uint_as_float(((unsigned)b) << 16); }
__device__ __forceinline__ float bflo(unsigned w) { return __uint_as_float(w << 16); }
__device__ __forceinline__ float bfhi(unsigned w) { return __uint_as_float(w & 0xffff0000u); }
__device__ __forceinline__ unsigned f2bf(float f) { unsigned u = __float_as_uint(f); return (u + 0x7fffu + ((u >> 16) & 1u)) >> 16; }
__device__ __forceinline__ unsigned pk2(float lo, float hi) { return pg8::cvt_pk_bf16(lo, hi); }
__device__ __forceinline__ float gelu_t(float x) {
    const float e = __builtin_amdgcn_exp2f(x * fmaf(x * x, -0.10294324f, -2.3022082f));
    return x * __builtin_amdgcn_rcpf(1.0f + e);
}
__device__ __forceinline__ float sigmoid_f(float x) { return __builtin_amdgcn_rcpf(1.0f + __builtin_amdgcn_exp2f(x * -1.4426950408889634f)); }
__device__ __forceinline__ float wave_sum(float v) {
#pragma unroll
    for (int o = 1; o < 64; o <<= 1) v += __shfl_xor(v, o);
    return v;
}
__device__ __forceinline__ float wave_max(float v) {
#pragma unroll
    for (int o = 1; o < 64; o <<= 1) v = fmaxf(v, __shfl_xor(v, o));
    return v;
}

struct Args {
    const float* in[22];
    float* out;
    unsigned char* ws;
    int ph_lo, ph_hi;
};


#define XB_TMO      128
#define XB_XCNT(j)  (256  + 64 * (j))
#define XB_XSUB(j)  (1280 + 64 * (j))
#define XB_XGEN(j)  (2304 + 64 * (j))
#define XB_TOP      3328
#define XB_TOPGEN   3392
#define XCD_BAR_WORDS 3456
#define XB_SPIN_CAP (1u << 22)
__device__ __forceinline__ unsigned xb_ld(unsigned* p)              { return __hip_atomic_load(p, __ATOMIC_RELAXED, __HIP_MEMORY_SCOPE_AGENT); }
__device__ __forceinline__ unsigned xb_add(unsigned* p, unsigned v) { return __hip_atomic_fetch_add(p, v, __ATOMIC_RELAXED, __HIP_MEMORY_SCOPE_AGENT); }
__device__ __forceinline__ unsigned xb_xcc_id() { return (unsigned)__builtin_amdgcn_s_getreg((3 << 11) | 20) & 0xFu; }
#define XB_SPIN(cond, bar) do { unsigned _sp = 0; while (cond) { __builtin_amdgcn_s_sleep(1); \
    if ((++_sp & 255u) == 0u) { if (xb_ld(&(bar)[XB_TMO])) break; if (_sp > XB_SPIN_CAP) { atomicAdd(&(bar)[XB_TMO], 1u); break; } } } } while (0)
struct XcdBarrier { unsigned* bar; unsigned x; volatile __attribute__((address_space(3))) unsigned* st; };
__device__ __forceinline__ XcdBarrier xcd_barrier_post(unsigned* bar, volatile __attribute__((address_space(3))) unsigned* st) {
    XcdBarrier b; b.bar = bar; b.x = xb_xcc_id(); b.st = st;
    if (threadIdx.x == 0) (void)xb_add(&bar[XB_XCNT(b.x)], 1u);
    return b;
}
__device__ __forceinline__ void xcd_barrier_complete(unsigned* bar, unsigned x, unsigned& nloc, unsigned& nx) {
    const unsigned G = gridDim.x * gridDim.y * gridDim.z;
    unsigned sum, cnt, mine, sp = 0u;
    for (;;) {
        sum = 0u; cnt = 0u; mine = 0u;
#pragma unroll
        for (unsigned j = 0; j < 16; ++j) { const unsigned c = xb_ld(&bar[XB_XCNT(j)]); sum += c; cnt += (c > 0u) ? 1u : 0u; mine = (j == x) ? c : mine; }
        if (sum == G) break;
        __builtin_amdgcn_s_sleep(1);
        if ((++sp & 255u) == 0u) { if (xb_ld(&bar[XB_TMO])) break; if (sp > XB_SPIN_CAP) { atomicAdd(&bar[XB_TMO], 1u); break; } }
    }
    nloc = mine > 0u ? mine : 1u; nx = cnt > 0u ? cnt : 1u;
}
__device__ __forceinline__ void xcd_barrier(const XcdBarrier& b) {
    asm volatile("s_waitcnt vmcnt(0)" ::: "memory");
    __syncthreads();
    if (threadIdx.x == 0) {
        unsigned* bar = b.bar;
        __builtin_amdgcn_s_waitcnt(0);
        unsigned nloc = b.st[0], nx = b.st[1];
        if (nloc == 0u) { xcd_barrier_complete(bar, b.x, nloc, nx); b.st[0] = nloc; b.st[1] = nx; }
        const unsigned old = xb_add(&bar[XB_XSUB(b.x)], 1u);
        const unsigned gen = old / nloc;
        if (old + 1u == (gen + 1u) * nloc) {
            __builtin_amdgcn_fence(__ATOMIC_RELEASE, "agent");
            asm volatile("s_waitcnt vmcnt(0)" ::: "memory");
            const unsigned og = xb_add(&bar[XB_TOP], 1u);
            const unsigned tg = og / nx;
            if (og + 1u == (tg + 1u) * nx) xb_add(&bar[XB_TOPGEN], 1u);
            else XB_SPIN(xb_ld(&bar[XB_TOPGEN]) == tg, bar);
            __builtin_amdgcn_fence(__ATOMIC_ACQUIRE, "agent");
            xb_add(&bar[XB_XGEN(b.x)], 1u);
            asm volatile("s_waitcnt vmcnt(0)" ::: "memory");
        } else {
            XB_SPIN(xb_ld(&bar[XB_XGEN(b.x)]) == gen, bar);
            __builtin_amdgcn_fence(__ATOMIC_ACQUIRE, "agent");
            asm volatile("s_waitcnt vmcnt(0)" ::: "memory");
        }
    }
    __syncthreads();
}

using pg8::Unit;
struct Epi0 {
    static constexpr bool PERM = false, AFTER_DRAIN = false, HAS_MID = false, USES_LDS = false;
    unsigned char* ws; int pn_off;
    template <int ACT> __device__ __forceinline__ void store(const f32x4 (&acc)[2][2][4][2], bf16* base, int ldc, int colbase, const Unit& u, int wr, int wc, int fr, int fq) const {
        const int row0 = u.pm * 256 + wr * 64 + fr, col0 = colbase + wc * 32 + 4 * fq;
#pragma unroll
        for (int ai = 0; ai < 2; ++ai)
#pragma unroll
            for (int m = 0; m < 4; ++m) { bf16* rowp = base + (size_t)(row0 + ai * 128 + m * 16) * ldc + col0;
#pragma unroll
                for (int bj = 0; bj < 2; ++bj)
#pragma unroll
                    for (int n = 0; n < 2; ++n) { f32x4 v = acc[ai][bj][m][n];
                        if (ACT == 0) { v = v * QSCALE; }
                        if (ACT == 2) { v[0] = gelu_t(v[0]); v[1] = gelu_t(v[1]); v[2] = gelu_t(v[2]); v[3] = gelu_t(v[3]); }
                        if (ACT == 3) { v[0] = sigmoid_f(v[0]); v[1] = sigmoid_f(v[1]); v[2] = sigmoid_f(v[2]); v[3] = sigmoid_f(v[3]); }
                        u32x2 w; w.x = pk2(v[0], v[1]); w.y = pk2(v[2], v[3]);
                        *(u32x2*)(rowp + bj * 128 + n * 16) = w; } }
    }
    __device__ __forceinline__ void operator()(const f32x4 (&acc)[2][2][4][2], const Unit& u, int wr, int wc, int fr, int fq) const {
        const int pn = u.pn + pn_off;
        if (pn < 4) store<0>(acc, (bf16*)(ws + WS_Q), 1024, pn * 256, u, wr, wc, fr, fq);
        else if (pn < 6) {
            bf16* base = (bf16*)(ws + WS_KV) + (size_t)(pn - 4) * T * 256; const int row0 = u.pm * 256 + wr * 64 + fr;
#pragma unroll
            for (int ai = 0; ai < 2; ++ai)
#pragma unroll
                for (int m = 0; m < 4; ++m)
#pragma unroll
                    for (int bj = 0; bj < 2; ++bj)
#pragma unroll
                        for (int n = 0; n < 2; ++n) { const f32x4 v = acc[ai][bj][m][n]; u32x2 w; w.x = pk2(v[0], v[1]); w.y = pk2(v[2], v[3]);
                            *(u32x2*)(base + (size_t)bj * T * 128 + (size_t)(row0 + ai * 128 + m * 16) * 128 + wc * 32 + n * 16 + 4 * fq) = w; }
        }
        else if (pn < 10) store<1>(acc, (bf16*)(ws + WS_KV) + (size_t)(pn - 4) * T * 256, 256, 0, u, wr, wc, fr, fq);
        else if (pn < 14) store<2>(acc, (bf16*)(ws + WS_U), 1024, (pn - 10) * 256, u, wr, wc, fr, fq);
        else if (pn < 18) {
            bf16* base = (bf16*)(ws + WS_V); float* vs = (float*)(ws + WS_VSTAT); const int row0 = u.pm * 256 + wr * 64 + fr, col0 = (pn - 14) * 256 + wc * 32 + 4 * fq;
#pragma unroll
            for (int ai = 0; ai < 2; ++ai)
#pragma unroll
                for (int m = 0; m < 4; ++m) { const int row = row0 + ai * 128 + m * 16; bf16* rowp = base + (size_t)row * 1024 + col0; float s1 = 0.f, s2 = 0.f;
#pragma unroll
                    for (int bj = 0; bj < 2; ++bj)
#pragma unroll
                        for (int n = 0; n < 2; ++n) { const f32x4 v = acc[ai][bj][m][n];
                            const float q0 = gelu_t(v[0]), q1 = gelu_t(v[1]), q2 = gelu_t(v[2]), q3 = gelu_t(v[3]);
                            s1 += (q0 + q1) + (q2 + q3); s2 += (q0 * q0 + q1 * q1) + (q2 * q2 + q3 * q3);
                            u32x2 w; w.x = pk2(q0, q1); w.y = pk2(q2, q3); *(u32x2*)(rowp + bj * 128 + n * 16) = w; }
                    s1 += __shfl_xor(s1, 16); s1 += __shfl_xor(s1, 32); s2 += __shfl_xor(s2, 16); s2 += __shfl_xor(s2, 32);
                    if (fq == 0) { float* o = vs + ((size_t)row * 16 + (pn - 14) * 4 + wc) * 2; o[0] = s1; o[1] = s2; }
                    asm volatile("" ::: "memory"); }
        }
        else if (pn < 26) store<3>(acc, (bf16*)(ws + WS_GA), 2048, (pn - 18) * 256, u, wr, wc, fr, fq);
        else if (pn < 31) store<3>(acc, (bf16*)(ws + WS_GB), 2048, (pn - 26) * 256, u, wr, wc, fr, fq);
        else if (pn >= 32) store<3>(acc, (bf16*)(ws + WS_GB), 2048, (pn - 27) * 256, u, wr, wc, fr, fq);
        else {
            float* ng = (float*)(ws + WS_NSAG);
            if (wc == 0) {
                const int row0 = u.pm * 256 + wr * 64 + fr;
#pragma unroll
                for (int ai = 0; ai < 2; ++ai)
#pragma unroll
                    for (int m = 0; m < 4; ++m)
#pragma unroll
                        for (int n = 0; n < 2; ++n) { const int c = 16 * n + 4 * fq;
                            if (c < 24) { f32x4 v = acc[ai][0][m][n]; f32x4 o; o[0] = sigmoid_f(v[0]); o[1] = sigmoid_f(v[1]); o[2] = sigmoid_f(v[2]); o[3] = sigmoid_f(v[3]);
                                *(f32x4*)(ng + (size_t)(row0 + ai * 128 + m * 16) * 24 + c) = o; } }
            }
        }
    }
};
constexpr float GB_MIN = 1.0e-6f;
struct EpiMix {
    static constexpr bool PERM = false, AFTER_DRAIN = false, HAS_MID = true, USES_LDS = false;
    const bf16* ga; const bf16* gb; bf16* out;
    __device__ __forceinline__ void operator()(f32x4 (&acc)[2][2][4][2], const Unit& u, int wr, int wc, int fr, int fq) const {
        const int row0 = u.pm * 256 + wr * 64 + fr, col0 = u.pn * 256 + wc * 32 + 4 * fq;
        if (u.kh == 0) {
#pragma unroll
            for (int ai = 0; ai < 2; ++ai)
#pragma unroll
                for (int m = 0; m < 4; ++m) { const size_t ro = (size_t)(row0 + ai * 128 + m * 16) * 2048 + col0;
#pragma unroll
                    for (int bj = 0; bj < 2; ++bj)
#pragma unroll
                        for (int n = 0; n < 2; ++n) { const size_t o = ro + bj * 128 + n * 16; const u32x2 aw = *(const u32x2*)(ga + o), bw = *(const u32x2*)(gb + o);
                            f32x4 v = acc[ai][bj][m][n];
                            v[0] *= bflo(aw.x) * __builtin_amdgcn_rcpf(fmaxf(bflo(bw.x), GB_MIN)); v[1] *= bfhi(aw.x) * __builtin_amdgcn_rcpf(fmaxf(bfhi(bw.x), GB_MIN));
                            v[2] *= bflo(aw.y) * __builtin_amdgcn_rcpf(fmaxf(bflo(bw.y), GB_MIN)); v[3] *= bfhi(aw.y) * __builtin_amdgcn_rcpf(fmaxf(bfhi(bw.y), GB_MIN));
                            acc[ai][bj][m][n] = v; }
                    asm volatile("" ::: "memory"); }
        } else {
#pragma unroll
            for (int ai = 0; ai < 2; ++ai)
#pragma unroll
                for (int m = 0; m < 4; ++m) { const size_t ro = (size_t)(row0 + ai * 128 + m * 16) * 2048 + col0;
#pragma unroll
                    for (int bj = 0; bj < 2; ++bj)
#pragma unroll
                        for (int n = 0; n < 2; ++n) { const f32x4 v = acc[ai][bj][m][n]; const size_t o = ro + bj * 128 + n * 16;
                            const u32x2 gw = *(const u32x2*)(gb + o);
                            u32x2 w; w.x = pk2(v[0] * fmaxf(bflo(gw.x), GB_MIN), v[1] * fmaxf(bfhi(gw.x), GB_MIN)); w.y = pk2(v[2] * fmaxf(bflo(gw.y), GB_MIN), v[3] * fmaxf(bfhi(gw.y), GB_MIN));
                            *(u32x2*)(out + o) = w; } }
        }
    }
};
struct EpiRes {
    static constexpr bool PERM = false, AFTER_DRAIN = false, HAS_MID = false, USES_LDS = false;
    const float* xi; float* xo; bf16* xb; float* part;
    __device__ __forceinline__ void operator()(const f32x4 (&acc)[2][2][4][2], const Unit& u, int wr, int wc, int fr, int fq) const {
        const int row0 = u.pm * 256 + wr * 64 + fr, col0 = u.pn * 256 + wc * 32 + 4 * fq;
#pragma unroll
        for (int ai = 0; ai < 2; ++ai)
#pragma unroll
            for (int m = 0; m < 4; ++m) { const int row = row0 + ai * 128 + m * 16; const size_t ro = (size_t)row * 2048 + col0; float ss = 0.f;
#pragma unroll
                for (int bj = 0; bj < 2; ++bj)
#pragma unroll
                    for (int n = 0; n < 2; ++n) { const size_t o = ro + bj * 128 + n * 16;
                        const f32x4 v = acc[ai][bj][m][n] + *(const f32x4*)(xi + o);
                        if (xo) *(f32x4*)(xo + o) = v;
                        ss += (v[0] * v[0] + v[1] * v[1]) + (v[2] * v[2] + v[3] * v[3]);
                        if (xb) { u32x2 w; w.x = pk2(v[0], v[1]); w.y = pk2(v[2], v[3]); *(u32x2*)(xb + o) = w; } }
                ss += __shfl_xor(ss, 16); ss += __shfl_xor(ss, 32);
                if (fq == 0) part[(size_t)row * 32 + u.pn * 4 + wc] = ss; }
    }
};
struct EpiResB {
    static constexpr bool PERM = false, AFTER_DRAIN = false, HAS_MID = false, USES_LDS = false;
    bf16* xb; float* part;
    __device__ __forceinline__ void operator()(const f32x4 (&acc)[2][2][4][2], const Unit& u, int wr, int wc, int fr, int fq) const {
        const int row0 = u.pm * 256 + wr * 64 + fr, col0 = u.pn * 256 + wc * 32 + 4 * fq;
#pragma unroll
        for (int ai = 0; ai < 2; ++ai)
#pragma unroll
            for (int m = 0; m < 4; ++m) { const int row = row0 + ai * 128 + m * 16; const size_t ro = (size_t)row * 2048 + col0; float ss = 0.f;
#pragma unroll
                for (int bj = 0; bj < 2; ++bj)
#pragma unroll
                    for (int n = 0; n < 2; ++n) { const size_t o = ro + bj * 128 + n * 16; const u32x2 xw = *(const u32x2*)(xb + o);
                        f32x4 v = acc[ai][bj][m][n]; v[0] += bflo(xw.x); v[1] += bfhi(xw.x); v[2] += bflo(xw.y); v[3] += bfhi(xw.y);
                        ss += (v[0] * v[0] + v[1] * v[1]) + (v[2] * v[2] + v[3] * v[3]);
                        u32x2 w; w.x = pk2(v[0], v[1]); w.y = pk2(v[2], v[3]); *(u32x2*)(xb + o) = w; }
                ss += __shfl_xor(ss, 16); ss += __shfl_xor(ss, 32);
                if (fq == 0) part[(size_t)row * 32 + u.pn * 4 + wc] = ss; }
    }
};
template <int CTRL> __device__ __forceinline__ float dpp_z(float v) { return __uint_as_float((unsigned)__builtin_amdgcn_update_dpp(0, (int)__float_as_uint(v), CTRL, 0xF, 0xF, true)); }
template <int CTRL> __device__ __forceinline__ float dpp_m(float old, float v) { return __uint_as_float((unsigned)__builtin_amdgcn_update_dpp((int)__float_as_uint(old), (int)__float_as_uint(v), CTRL, 0xF, 0xF, false)); }
#define DPP_SHR1 0x111
#define DPP_SHR2 0x112
#define DPP_SHL14 0x10E
#define DPP_SHL15 0x10F
struct EpiFfnConv {
    static constexpr bool PERM = false, AFTER_DRAIN = false, HAS_MID = false, USES_LDS = false;
    const float* part; const float* cw; const float* cb; bf16* gout;
    __device__ __forceinline__ void operator()(f32x4 (&acc)[2][2][4][2], const Unit& u, int wr, int wc, int fr, int fq) const {
        const int jcol0 = u.pn * 128 + wc * 32 + 4 * fq;
        f32x4 w0, w1, w2, bb;
        w0 = *(const f32x4*)(cw + jcol0); w1 = *(const f32x4*)(cw + DFF + jcol0); w2 = *(const f32x4*)(cw + 2 * DFF + jcol0); bb = *(const f32x4*)(cb + jcol0);
#pragma unroll
        for (int ai = 0; ai < 2; ++ai) { const int rbase = 62 * (4 * u.pm + 2 * ai + wr) - 2 + fr;
#pragma unroll
            for (int m = 0; m < 4; ++m) { int row = rbase + 16 * m; row = row < 0 ? 0 : (row > T - 1 ? T - 1 : row);
                const f32x4 p0 = *(const f32x4*)(part + (size_t)row * 32 + fq * 8), p1 = *(const f32x4*)(part + (size_t)row * 32 + fq * 8 + 4);
                float ss = ((p0[0] + p0[1]) + (p0[2] + p0[3])) + ((p1[0] + p1[1]) + (p1[2] + p1[3]));
                ss += __shfl_xor(ss, 16); ss += __shfl_xor(ss, 32);
                const float r = rsqrtf(ss * (1.0f / 2048.0f) + NORM_EPS);
#pragma unroll
                for (int bj = 0; bj < 2; ++bj)
#pragma unroll
                    for (int n = 0; n < 2; ++n) acc[ai][bj][m][n] = acc[ai][bj][m][n] * r; } }
        if (u.pm == 0 && wr == 0 && fr < 2) { acc[0][0][0][0] = (f32x4){0.f, 0.f, 0.f, 0.f}; acc[0][0][0][1] = (f32x4){0.f, 0.f, 0.f, 0.f}; }
#pragma unroll
        for (int n = 0; n < 2; ++n) { const int j = jcol0 + 16 * n;
            if (n == 1) { w0 = *(const f32x4*)(cw + j); w1 = *(const f32x4*)(cw + DFF + j); w2 = *(const f32x4*)(cw + 2 * DFF + j); bb = *(const f32x4*)(cb + j); }
#pragma unroll
            for (int ai = 0; ai < 2; ++ai) { const int rbase = 62 * (4 * u.pm + 2 * ai + wr) - 2 + fr;
#pragma unroll
                for (int m = 0; m < 4; ++m) {
                    const f32x4 cur = acc[ai][0][m][n]; f32x4 o;
#pragma unroll
                    for (int e = 0; e < 4; ++e) {
                        float z1, z2;
                        if (m > 0) { const float pm_ = acc[ai][0][m - 1][n][e]; z1 = dpp_m<DPP_SHR1>(dpp_z<DPP_SHL15>(pm_), cur[e]); z2 = dpp_m<DPP_SHR2>(dpp_z<DPP_SHL14>(pm_), cur[e]); }
                        else { z1 = dpp_z<DPP_SHR1>(cur[e]); z2 = dpp_z<DPP_SHR2>(cur[e]); }
                        const float y = fmaf(w0[e], z2, fmaf(w1[e], z1, fmaf(w2[e], cur[e], bb[e])));
                        o[e] = gelu_t(y) * acc[ai][1][m][n][e];
                    }
                    const int row = rbase + 16 * m;
                    if ((m > 0 || fr >= 2) && row < T) { u32x2 w; w.x = pk2(o[0], o[1]); w.y = pk2(o[2], o[3]); *(u32x2*)(gout + (size_t)(j >> 6) * (T * 64) + (size_t)row * 64 + (j & 63)) = w; }
                }
            }
        }
    }
};

struct Frame {
    unsigned char* lds;
    int tid, lane, wave, G, bid;
    unsigned char* ws;
};

__device__ __forceinline__ void transpose_item(const float* W, int ldw, int c0, int nvalid, const float* gain, bf16* WT, int ldk, int r0, int nblk, float* scr, int item, int lane, int kmul = 1) {
    const int kb = item / nblk, nb = item % nblk, k0 = 64 * kb, n0 = 32 * nb;
    const int nn = lane & 31; const bool ok = (n0 + nn) < nvalid;
    const float* src = W + (size_t)(k0 + (lane >> 5)) * ldw + c0 + n0 + nn;
    float v[32];
#pragma unroll
    for (int i = 0; i < 32; ++i) v[i] = ok ? src[(size_t)(2 * i) * ldw] : 0.f;
#pragma unroll
    for (int i = 0; i < 32; ++i) scr[(2 * i + (lane >> 5)) * 33 + nn] = v[i];
    asm volatile("s_waitcnt lgkmcnt(0)" ::: "memory");
    const int c = lane & 7;
    f32x4 g0 = {1.f, 1.f, 1.f, 1.f}, g1 = g0;
    if (gain) { g0 = *(const f32x4*)(gain + k0 + 8 * c); g1 = *(const f32x4*)(gain + k0 + 8 * c + 4); }
#pragma unroll
    for (int j = 0; j < 4; ++j) { const int n = (lane >> 3) + 8 * j; const float* s = scr + (8 * c) * 33 + n;
        u32x4 o; o.x = pk2(s[0 * 33] * g0[0], s[1 * 33] * g0[1]); o.y = pk2(s[2 * 33] * g0[2], s[3 * 33] * g0[3]); o.z = pk2(s[4 * 33] * g1[0], s[5 * 33] * g1[1]); o.w = pk2(s[6 * 33] * g1[2], s[7 * 33] * g1[3]);
        *(u32x4*)(WT + (size_t)(r0 + n0 + n) * ldk + (size_t)k0 * kmul + 8 * c) = o; }
    asm volatile("s_waitcnt lgkmcnt(0)" ::: "memory");
}
__device__ __forceinline__ void p0_prologue(const Frame& F, const Args& A) {
    float* scr = (float*)(F.lds + F.wave * 16384);
    const int gw = F.bid * NWAVES + F.wave, NGW = F.G * NWAVES;
    unsigned char* ws = F.ws;
    constexpr int I_IN1 = 32 * (2560 / 32), I_IN2 = 32 * (5376 / 32), I_IN3 = 32 * (256 / 32), I_IN4 = 32 * (768 / 32);
    constexpr int I_OUT = 32 * (2048 / 32), I_PA = 16 * (2048 / 32);
    constexpr int I_W1 = 64 * 4, I_W2 = 2 * 4;
    constexpr int NITEMS = I_IN1 + I_IN2 + I_IN3 + I_IN4 + I_OUT + 2 * I_PA + 2 * I_W1 + 2 * I_W2;
    for (int it = gw; it < NITEMS; it += NGW) {
        int r = it;
        if (r < I_IN1) { transpose_item(A.in[2], INW, 0, 2560, A.in[1], (bf16*)(ws + WS_WIN), 2048, 0, 2560 / 32, scr, r, F.lane); continue; } r -= I_IN1;
        if (r < I_IN2) { transpose_item(A.in[2], INW, 2584, 5376, A.in[1], (bf16*)(ws + WS_WIN), 2048, 2560, 5376 / 32, scr, r, F.lane); continue; } r -= I_IN2;
        if (r < I_IN3) { transpose_item(A.in[2], INW, 2560, 24, A.in[1], (bf16*)(ws + WS_WIN), 2048, 7936, 256 / 32, scr, r, F.lane); continue; } r -= I_IN3;
        if (r < I_IN4) { transpose_item(A.in[2], INW, 7960, 768, A.in[1], (bf16*)(ws + WS_WIN), 2048, 8192, 768 / 32, scr, r, F.lane); continue; } r -= I_IN4;
        if (r < I_OUT) { transpose_item(A.in[15], 2048, 0, 2048, nullptr, (bf16*)(ws + WS_WOUT), 2048, 0, 2048 / 32, scr, r, F.lane); continue; } r -= I_OUT;
        if (r < I_PA) { transpose_item(A.in[13], 2048, 0, 2048, nullptr, (bf16*)(ws + WS_WPA), 2048, 0, 2048 / 32, scr, r, F.lane); continue; } r -= I_PA;
        if (r < I_PA) { transpose_item(A.in[14], 2048, 0, 2048, nullptr, (bf16*)(ws + WS_WPB), 2048, 0, 2048 / 32, scr, r, F.lane); continue; } r -= I_PA;
        if (r < I_W1) { transpose_item(A.in[4], 128, 0, 128, nullptr, (bf16*)(ws + WS_W1T), 4096, 0, 4, scr, r, F.lane); continue; } r -= I_W1;
        if (r < I_W1) { transpose_item(A.in[7], 128, 0, 128, nullptr, (bf16*)(ws + WS_W1T) + 128 * 4096, 4096, 0, 4, scr, r, F.lane); continue; } r -= I_W1;
        if (r < I_W2) { transpose_item(A.in[5], 128, 0, 128, nullptr, (bf16*)(ws + WS_W2T), 128, 0, 4, scr, r, F.lane); continue; } r -= I_W2;
        transpose_item(A.in[8], 128, 0, 128, nullptr, (bf16*)(ws + WS_W2T) + 128 * 128, 128, 0, 4, scr, r, F.lane);
    }
    const float* x = A.in[0]; bf16* h = (bf16*)(ws + WS_H);
    for (int m0 = gw; m0 < T; m0 += 2 * NGW) {
        const int m1 = m0 + NGW; const bool has1 = m1 < T; const int m1c = has1 ? m1 : m0;
        const f32x4* xa = (const f32x4*)(x + (size_t)m0 * DM) + F.lane; const f32x4* xb = (const f32x4*)(x + (size_t)m1c * DM) + F.lane;
        f32x4 va[8], vb[8]; float sa = 0.f, sb = 0.f;
#pragma unroll
        for (int j = 0; j < 8; ++j) { va[j] = xa[64 * j]; vb[j] = xb[64 * j]; }
#pragma unroll
        for (int j = 0; j < 8; ++j) { sa += (va[j][0] * va[j][0] + va[j][1] * va[j][1]) + (va[j][2] * va[j][2] + va[j][3] * va[j][3]); sb += (vb[j][0] * vb[j][0] + vb[j][1] * vb[j][1]) + (vb[j][2] * vb[j][2] + vb[j][3] * vb[j][3]); }
        const float ra = rsqrtf(wave_sum(sa) * (1.0f / DM) + NORM_EPS), rb = rsqrtf(wave_sum(sb) * (1.0f / DM) + NORM_EPS);
        u32x2* oa = (u32x2*)(h + (size_t)m0 * DM) + F.lane; u32x2* ob = (u32x2*)(h + (size_t)m1c * DM) + F.lane;
#pragma unroll
        for (int j = 0; j < 8; ++j) { u32x2 w; w.x = pk2(va[j][0] * ra, va[j][1] * ra); w.y = pk2(va[j][2] * ra, va[j][3] * ra); oa[64 * j] = w; }
        if (has1) {
#pragma unroll
            for (int j = 0; j < 8; ++j) { u32x2 w; w.x = pk2(vb[j][0] * rb, vb[j][1] * rb); w.y = pk2(vb[j][2] * rb, vb[j][3] * rb); ob[64 * j] = w; } }
    }
}
__device__ __forceinline__ void convert_wffn(const Frame& F, const Args& A, int slot, int nslots) {
    float* scr = (float*)(F.lds + F.wave * 16384);
    constexpr int I_FFN = 32 * (11008 / 32);
    for (int r = slot * NWAVES + F.wave; r < I_FFN; r += nslots * NWAVES) { const int n0 = 32 * (r % (11008 / 32)); const int csrc = ((n0 >> 7) & 1) * DFF + (n0 >> 8) * 128 + (n0 & 127);
        transpose_item(A.in[17], 2 * DFF, csrc - n0, 2 * DFF, A.in[16], (bf16*)(F.ws + WS_WFFN), 2048, 0, 11008 / 32, scr, r, F.lane); }
}
__device__ __forceinline__ void convert_wdown(const Frame& F, const Args& A, int slot, int nslots) {
    float* scr = (float*)(F.lds + F.wave * 16384);
    constexpr int I_DOWN = (DFF / 64) * (2048 / 32);
    for (int r = slot * NWAVES + F.wave; r < I_DOWN; r += nslots * NWAVES) transpose_item(A.in[20], 2048, 0, 2048, nullptr, (bf16*)(F.ws + WS_WDOWN), 64, 0, 2048 / 32, scr, r, F.lane, 2048);
}

namespace p2 {
#define PLAS __attribute__((address_space(3)))
typedef short bf16x8 __attribute__((ext_vector_type(8)));
typedef short s16x4 __attribute__((ext_vector_type(4)));
typedef float f32x16 __attribute__((ext_vector_type(16)));
__device__ __forceinline__ s16x4 vtr(const PLAS char* p) { return __builtin_bit_cast(s16x4, __builtin_amdgcn_ds_read_tr16_b64_v4i16((PLAS s16x4*)p)); }
__device__ __forceinline__ bf16x8 pack8(const float (&v)[8]) { u32x4 w; w.x = pk2(v[0], v[1]); w.y = pk2(v[2], v[3]); w.z = pk2(v[4], v[5]); w.w = pk2(v[6], v[7]); return __builtin_bit_cast(bf16x8, w); }
__device__ __forceinline__ void unpack8(const u32x4 w, float (&v)[8]) { v[0] = bflo(w.x); v[1] = bfhi(w.x); v[2] = bflo(w.y); v[3] = bfhi(w.y); v[4] = bflo(w.z); v[5] = bfhi(w.z); v[6] = bflo(w.w); v[7] = bfhi(w.w); }
constexpr int CP_STR = 132;
constexpr int CP_HB = 8 * 32 * CP_STR * 4;
__device__ __forceinline__ void compress_item(const Frame& F, const Args& A, int item) {
    PLAS char* L = (PLAS char*)F.lds; const int lane = F.lane, wave = F.wave, c = lane & 31, hf = lane >> 5;
    const int kvsel = item >> 5, g = (item >> 4) & 1, n0 = (item & 15) * 32;
    const bf16* Ab = (const bf16*)(F.ws + WS_KV) + (size_t)kvsel * T * 256 + (size_t)g * T * 128 + (size_t)(n0 + c) * 2048 + wave * 512 + 8 * hf;
    const float* peg = A.in[kvsel ? 6 : 3];
    PLAS float* pel = (PLAS float*)L;
    __syncthreads();
    for (int e = F.tid; e < 1024; e += NTHR) *(PLAS f32x4*)(pel + 4 * e) = *(const f32x4*)(peg + 4 * e);
    __syncthreads();
    const PLAS float* pe = pel + wave * 512 + 8 * hf;
    const bf16* Bb = (const bf16*)(F.ws + WS_W1T) + (size_t)kvsel * 128 * 4096 + (size_t)c * 4096 + wave * 512 + 8 * hf;
    f32x16 acc[4];
#pragma unroll
    for (int cb = 0; cb < 4; ++cb)
#pragma unroll
        for (int r = 0; r < 16; ++r) acc[cb][r] = 0.f;
#pragma unroll 8
    for (int ks = 0; ks < 32; ++ks) {
        const u32x4 aw = *(const u32x4*)(Ab + 16 * ks); const f32x4 p0 = *(const PLAS f32x4*)(pe + 16 * ks), p1 = *(const PLAS f32x4*)(pe + 16 * ks + 4);
        float av[8]; unpack8(aw, av);
        av[0] += p0[0]; av[1] += p0[1]; av[2] += p0[2]; av[3] += p0[3]; av[4] += p1[0]; av[5] += p1[1]; av[6] += p1[2]; av[7] += p1[3];
        const bf16x8 af = pack8(av);
#pragma unroll
        for (int cb = 0; cb < 4; ++cb) { const bf16x8 bfr = *(const bf16x8*)(Bb + (size_t)cb * 32 * 4096 + 16 * ks); acc[cb] = __builtin_amdgcn_mfma_f32_32x32x16_bf16(af, bfr, acc[cb], 0, 0, 0); }
    }
    __syncthreads();
    PLAS float* part = (PLAS float*)L + wave * 32 * CP_STR;
#pragma unroll
    for (int cb = 0; cb < 4; ++cb)
#pragma unroll
        for (int r = 0; r < 16; ++r) part[((r & 3) + 8 * (r >> 2) + 4 * hf) * CP_STR + cb * 32 + c] = acc[cb][r];
    __syncthreads();
    PLAS char* hb = L + CP_HB;
    for (int e = F.tid; e < 32 * 128; e += NTHR) { const int row = e >> 7, col = e & 127; float sum = 0.f;
#pragma unroll
        for (int w = 0; w < 8; ++w) sum += ((PLAS float*)L)[(w * 32 + row) * CP_STR + col];
        *(PLAS unsigned short*)(hb + row * 272 + col * 2) = (unsigned short)f2bf(gelu_t(sum)); }
    __syncthreads();
    if (wave < 4) {
        const bf16* B2 = (const bf16*)(F.ws + WS_W2T) + (size_t)kvsel * 128 * 128 + (size_t)(wave * 32 + c) * 128 + 8 * hf;
        f32x16 o;
#pragma unroll
        for (int r = 0; r < 16; ++r) o[r] = 0.f;
#pragma unroll
        for (int ks = 0; ks < 8; ++ks) { const bf16x8 af = *(const PLAS bf16x8*)(hb + c * 272 + (16 * ks + 8 * hf) * 2); const bf16x8 bfr = *(const bf16x8*)(B2 + 16 * ks);
            o = __builtin_amdgcn_mfma_f32_32x32x16_bf16(af, bfr, o, 0, 0, 0); }
        bf16* dst = (bf16*)(F.ws + WS_KC) + (size_t)kvsel * 2 * 512 * 128 + (size_t)g * 512 * 128;
#pragma unroll
        for (int r = 0; r < 16; ++r) { const int n = n0 + (r & 3) + 8 * (r >> 2) + 4 * hf; dst[(size_t)n * 128 + wave * 32 + c] = (bf16)(n < 511 ? f2bf(o[r]) : 0u); }
    }
    __syncthreads();
}
constexpr int SG_STR = 320;
__device__ __forceinline__ void sgu_item(const Frame& F, const Args& A, int item) {
    PLAS char* L = (PLAS char*)F.lds; const int tid = F.tid, lane = F.lane, wave = F.wave, c = lane & 31, hf = lane >> 5;
    const int ch = item >> 3, g = item & 7;
    const bf16* gu = (const bf16*)(F.ws + WS_U); const bf16* gv = (const bf16*)(F.ws + WS_V); bf16* yb = (bf16*)(F.ws + WS_YB);
    const float* vs = (const float*)(F.ws + WS_VSTAT);
    const float* ln_g = A.in[9]; const float* ln_b = A.in[10]; const float* sw = A.in[11] + (size_t)g * 128 * 128; const float* sb = A.in[12] + g * 128;
    PLAS float* st = (PLAS float*)(L + 128 * SG_STR);
    const int tb = wave >> 1, cb0 = (wave & 1) * 2, t = 32 * tb + c;
    f32x4 sp[8];
    { const f32x4* p = (const f32x4*)(vs + (size_t)(ch * 128 + (tid & 127)) * 32);
#pragma unroll
      for (int i = 0; i < 8; ++i) sp[i] = p[i]; }
    u32x4 vw[4]; f32x4 lg0[4], lg1[4], lb0[4], lb1[4];
#pragma unroll
    for (int i = 0; i < 4; ++i) { const int id = tid + NTHR * i, s = id >> 4, dc = id & 15;
        vw[i] = *(const u32x4*)(gv + (size_t)(ch * 128 + s) * SGW + g * 128 + dc * 8);
        lg0[i] = *(const f32x4*)(ln_g + g * 128 + dc * 8); lg1[i] = *(const f32x4*)(ln_g + g * 128 + dc * 8 + 4); lb0[i] = *(const f32x4*)(ln_b + g * 128 + dc * 8); lb1[i] = *(const f32x4*)(ln_b + g * 128 + dc * 8 + 4); }
    f32x4 wv[8][2];
#pragma unroll
    for (int ks = 0; ks < 8; ++ks) if (ks < 2 * tb + 2) { wv[ks][0] = *(const f32x4*)(sw + (size_t)t * 128 + 16 * ks + 8 * hf); wv[ks][1] = *(const f32x4*)(sw + (size_t)t * 128 + 16 * ks + 8 * hf + 4); }
    unsigned short guv[2][16]; float sbv[16];
#pragma unroll
    for (int r = 0; r < 16; ++r) { const int tt = 32 * tb + (r & 3) + 8 * (r >> 2) + 4 * hf; sbv[r] = sb[tt];
#pragma unroll
        for (int j = 0; j < 2; ++j) guv[j][r] = gu[(size_t)(ch * 128 + tt) * SGW + g * 128 + (cb0 + j) * 32 + c]; }
    if (tid < 128) { float s1 = 0.f, s2 = 0.f;
#pragma unroll
        for (int i = 0; i < 8; ++i) { s1 += sp[i][0] + sp[i][2]; s2 += sp[i][1] + sp[i][3]; }
        const float mean = s1 * (1.0f / SGW), var = fmaxf(s2 * (1.0f / SGW) - mean * mean, 0.f);
        st[2 * tid] = mean; st[2 * tid + 1] = rsqrtf(var + LN_EPS); }
    __syncthreads();
#pragma unroll
    for (int i = 0; i < 4; ++i) { const int id = tid + NTHR * i, s = id >> 4, dc = id & 15;
        float v[8]; unpack8(vw[i], v);
        const float mean = st[2 * s], rstd = st[2 * s + 1];
#pragma unroll
        for (int e = 0; e < 4; ++e) { v[e] = (v[e] - mean) * rstd * lg0[i][e] + lb0[i][e]; v[4 + e] = (v[4 + e] - mean) * rstd * lg1[i][e] + lb1[i][e]; }
        *(PLAS bf16x8*)(L + s * SG_STR + dc * 16) = pack8(v); }
    __syncthreads();
    f32x16 acc[2];
#pragma unroll
    for (int j = 0; j < 2; ++j)
#pragma unroll
        for (int r = 0; r < 16; ++r) acc[j][r] = 0.f;
    const PLAS char* vp = L + (8 * hf + ((lane & 15) >> 2)) * SG_STR + (16 * ((lane >> 4) & 1) + 4 * (lane & 3)) * 2;
#pragma unroll
    for (int ks = 0; ks < 8; ++ks) if (ks < 2 * tb + 2) {
        float av[8]; const int s0 = 16 * ks + 8 * hf;
#pragma unroll
        for (int e = 0; e < 4; ++e) { av[e] = (s0 + e <= t) ? wv[ks][0][e] : 0.f; av[4 + e] = (s0 + 4 + e <= t) ? wv[ks][1][e] : 0.f; }
        const bf16x8 af = pack8(av);
#pragma unroll
        for (int j = 0; j < 2; ++j) { const s16x4 lo = vtr(vp + 16 * ks * SG_STR + (cb0 + j) * 64), hi = vtr(vp + (16 * ks + 4) * SG_STR + (cb0 + j) * 64);
            const bf16x8 bfr = (bf16x8){lo[0], lo[1], lo[2], lo[3], hi[0], hi[1], hi[2], hi[3]};
            acc[j] = __builtin_amdgcn_mfma_f32_32x32x16_bf16(af, bfr, acc[j], 0, 0, 0); }
    }
#pragma unroll
    for (int j = 0; j < 2; ++j)
#pragma unroll
        for (int r = 0; r < 16; ++r) { const int tt = 32 * tb + (r & 3) + 8 * (r >> 2) + 4 * hf;
            yb[(size_t)(ch * 128 + tt) * YLD + g * 128 + (cb0 + j) * 32 + c] = (bf16)f2bf((acc[j][r] + sbv[r]) * bf2f(guv[j][r])); }
    __syncthreads();
}
}
constexpr int SGU_EARLY = 448;
__device__ __forceinline__ void p2_phase(const Frame& F, const Args& A, int b0) {
    const int nb = F.G - b0, b = F.bid - b0;
    if (b < 0) return;
    int it, step, end;
    if (nb >= 128) {
        if (b < 64) { p2::compress_item(F, A, b); it = b; step = 1; end = b + 1; }
        else { it = 64 + (b - 64); step = nb - 64; end = SGU_EARLY; }
    } else {
        for (int c = b; c < 64; c += nb) p2::compress_item(F, A, c);
        it = b; step = nb; end = SGU_EARLY;
    }
    for (; it < end; it += step) p2::sgu_item(F, A, it);
}

namespace nsa {
#define NLAS __attribute__((address_space(3)))
typedef short bf16x8 __attribute__((ext_vector_type(8)));
typedef short s16x4 __attribute__((ext_vector_type(4)));
typedef float f32x16 __attribute__((ext_vector_type(16)));
constexpr int IMPS = 132, KIMG = 16384, STG = 32768;
constexpr int L_IMP = 3 * STG, L_SELM = L_IMP + 64 * IMPS * 4, L_UM = L_SELM + 1024, L_TL = L_UM + 16, L_END = L_TL + 132 * 4;
static_assert(L_END <= LDS_BYTES - 16, "nsa LDS map");
constexpr float NEG = -1.0e30f, M_INIT = -1.0e20f, RESC_THR = 5.0f;

__device__ __forceinline__ void dma_k(const char* kt, int ks, NLAS char* kdst, int wave, int lane) {
    const char* src = kt + (size_t)lane * ks + wave * 32;
    __builtin_amdgcn_global_load_lds((const unsigned*)src, (NLAS unsigned*)(kdst + wave * 2048), 16, 0, 0);
    __builtin_amdgcn_global_load_lds((const unsigned*)(src + 16), (NLAS unsigned*)(kdst + wave * 2048 + 1024), 16, 0, 0);
}
__device__ __forceinline__ void dma_v(const char* vt, int vs, NLAS char* vdst, int wave, int lane) {
    const int db = wave >> 1, pr = 2 * (wave & 1);
    const char* src = vt + (size_t)(16 * pr + (lane >> 2)) * vs + db * 64 + (lane & 3) * 16;
    __builtin_amdgcn_global_load_lds((const unsigned*)src, (NLAS unsigned*)(vdst + db * 4096 + pr * 1024), 16, 0, 0);
    __builtin_amdgcn_global_load_lds((const unsigned*)(src + (size_t)16 * vs), (NLAS unsigned*)(vdst + db * 4096 + pr * 1024 + 1024), 16, 0, 0);
}
#define NSA_WAIT(n) asm volatile("s_waitcnt vmcnt(" #n ") lgkmcnt(0)" ::: "memory")
#define NSA_BAR() do { __builtin_amdgcn_s_barrier(); asm volatile("" ::: "memory"); } while (0)

__device__ __forceinline__ float swap_other(float v) {
    auto rr = __builtin_amdgcn_permlane32_swap(__float_as_uint(v), __float_as_uint(v), false, false);
    const unsigned lo = rr[0], hi = rr[1];
    return (threadIdx.x & 32) ? __uint_as_float(lo) : __uint_as_float(hi);
}
#define KCONST(kb, r) (32 * (kb) + ((r) & 3) + 8 * ((r) >> 2))
__device__ __forceinline__ void qk_tile(f32x16 (&S)[2], const NLAS char* kbuf, const bf16x8 (&qf)[8], float base2, float sl2p, int lane) {
    const NLAS char* kp = kbuf + (lane >> 5) * 1024 + (lane & 31) * 16;
#define QK_LD(d0, d1, ks) do { d0 = *(const NLAS bf16x8*)(kp + (ks) * 2048); d1 = *(const NLAS bf16x8*)(kp + (ks) * 2048 + 512); } while (0)
#define QK_MM(s0, s1, ks) do { S[0] = __builtin_amdgcn_mfma_f32_32x32x16_bf16(s0, qf[ks], S[0], 0, 0, 0); S[1] = __builtin_amdgcn_mfma_f32_32x32x16_bf16(s1, qf[ks], S[1], 0, 0, 0); } while (0)
#define SB() __builtin_amdgcn_sched_barrier(0)
    bf16x8 a0, a1, b0, b1;
    QK_LD(a0, a1, 0);
#pragma unroll
    for (int kb = 0; kb < 2; ++kb)
#pragma unroll
        for (int r = 0; r < 16; ++r) S[kb][r] = fmaf(sl2p, (float)KCONST(kb, r), base2);
    SB();
    QK_LD(b0, b1, 1); SB(); QK_MM(a0, a1, 0); SB();
    QK_LD(a0, a1, 2); SB(); QK_MM(b0, b1, 1); SB();
    QK_LD(b0, b1, 3); SB(); QK_MM(a0, a1, 2); SB();
    QK_LD(a0, a1, 4); SB(); QK_MM(b0, b1, 3); SB();
    QK_LD(b0, b1, 5); SB(); QK_MM(a0, a1, 4); SB();
    QK_LD(a0, a1, 6); SB(); QK_MM(b0, b1, 5); SB();
    QK_LD(b0, b1, 7); SB(); QK_MM(a0, a1, 6); SB();
    QK_MM(b0, b1, 7);
#undef QK_LD
#undef QK_MM
}
__device__ __forceinline__ void mask_tile(f32x16 (&S)[2], int dbase, int pscale, unsigned dmax) {
#pragma unroll
    for (int kb = 0; kb < 2; ++kb)
#pragma unroll
        for (int r = 0; r < 16; ++r) { const unsigned d = (unsigned)(dbase - pscale * KCONST(kb, r)); S[kb][r] = d < dmax ? S[kb][r] : NEG; }
}
__device__ __forceinline__ float tile_max(const f32x16 (&S)[2]) {
    float a = fmaxf(S[0][0], S[1][0]);
#pragma unroll
    for (int r = 1; r < 16; ++r) a = fmaxf(fmaxf(a, S[0][r]), S[1][r]);
    return fmaxf(a, swap_other(a));
}
__device__ __forceinline__ s16x4 vtr(const NLAS char* p) { return __builtin_bit_cast(s16x4, __builtin_amdgcn_ds_read_tr16_b64_v4i16((NLAS s16x4*)p)); }
__device__ __forceinline__ void pack_p(bf16x8 (&pf)[4], const f32x16 (&S)[2]) {
#pragma unroll
    for (int kb = 0; kb < 2; ++kb)
#pragma unroll
        for (int s = 0; s < 2; ++s) { u32x4 pw; pw.x = pk2(S[kb][8 * s + 0], S[kb][8 * s + 1]); pw.y = pk2(S[kb][8 * s + 2], S[kb][8 * s + 3]); pw.z = pk2(S[kb][8 * s + 4], S[kb][8 * s + 5]); pw.w = pk2(S[kb][8 * s + 6], S[kb][8 * s + 7]);
            pf[kb * 2 + s] = __builtin_bit_cast(bf16x8, pw); }
}
__device__ __forceinline__ void pv_tile(f32x16 (&O)[4], const bf16x8 (&pf)[4], const NLAS char* vbuf, int lane) {
    const NLAS char* vp = vbuf + (4 * (lane >> 5) + ((lane & 15) >> 2)) * 64 + 32 * ((lane >> 4) & 1) + 8 * (lane & 3);
#define PV_RD(x, off) asm volatile("ds_read_b64_tr_b16 %0, %1 offset:%2" : "=v"(x) : "v"(va), "n"(off))
#define PV_LD(l0, h0, l1, h1, g) do { PV_RD(l0, ((g) >> 1) * 1024 + (2 * ((g) & 1)) * 4096); PV_RD(h0, ((g) >> 1) * 1024 + 512 + (2 * ((g) & 1)) * 4096); \
                                      PV_RD(l1, ((g) >> 1) * 1024 + (2 * ((g) & 1) + 1) * 4096); PV_RD(h1, ((g) >> 1) * 1024 + 512 + (2 * ((g) & 1) + 1) * 4096); } while (0)
#define PV_WT(n, l0, h0, l1, h1) asm volatile("s_waitcnt lgkmcnt(" #n ")" : "+v"(l0), "+v"(h0), "+v"(l1), "+v"(h1))
#define PV_MM(l0, h0, l1, h1, g) do { O[2 * ((g) & 1)] = __builtin_amdgcn_mfma_f32_32x32x16_bf16((bf16x8){l0[0], l0[1], l0[2], l0[3], h0[0], h0[1], h0[2], h0[3]}, pf[(g) >> 1], O[2 * ((g) & 1)], 0, 0, 0); \
                                      O[2 * ((g) & 1) + 1] = __builtin_amdgcn_mfma_f32_32x32x16_bf16((bf16x8){l1[0], l1[1], l1[2], l1[3], h1[0], h1[1], h1[2], h1[3]}, pf[(g) >> 1], O[2 * ((g) & 1) + 1], 0, 0, 0); } while (0)
    const unsigned va = (unsigned)(size_t)vp;
    s16x4 la0, ha0, la1, ha1, lb0, hb0, lb1, hb1;
    PV_LD(la0, ha0, la1, ha1, 0); SB();
    PV_LD(lb0, hb0, lb1, hb1, 1); SB(); PV_WT(4, la0, ha0, la1, ha1); PV_MM(la0, ha0, la1, ha1, 0); SB();
    PV_LD(la0, ha0, la1, ha1, 2); SB(); PV_WT(4, lb0, hb0, lb1, hb1); PV_MM(lb0, hb0, lb1, hb1, 1); SB();
    PV_LD(lb0, hb0, lb1, hb1, 3); SB(); PV_WT(4, la0, ha0, la1, ha1); PV_MM(la0, ha0, la1, ha1, 2); SB();
    PV_LD(la0, ha0, la1, ha1, 4); SB(); PV_WT(4, lb0, hb0, lb1, hb1); PV_MM(lb0, hb0, lb1, hb1, 3); SB();
    PV_LD(lb0, hb0, lb1, hb1, 5); SB(); PV_WT(4, la0, ha0, la1, ha1); PV_MM(la0, ha0, la1, ha1, 4); SB();
    PV_LD(la0, ha0, la1, ha1, 6); SB(); PV_WT(4, lb0, hb0, lb1, hb1); PV_MM(lb0, hb0, lb1, hb1, 5); SB();
    PV_LD(lb0, hb0, lb1, hb1, 7); SB(); PV_WT(4, la0, ha0, la1, ha1); PV_MM(la0, ha0, la1, ha1, 6); SB();
    PV_WT(0, lb0, hb0, lb1, hb1); PV_MM(lb0, hb0, lb1, hb1, 7);
#undef PV_RD
#undef PV_WT
#undef PV_LD
#undef PV_MM
#undef SB
}
__device__ __forceinline__ void pv_sm_tile(f32x16 (&O)[4], bf16x8 (&pf)[4], const NLAS char* vbuf, int lane, f32x16 (&S)[2], float& ls) {
    const NLAS char* vp = vbuf + (4 * (lane >> 5) + ((lane & 15) >> 2)) * 64 + 32 * ((lane >> 4) & 1) + 8 * (lane & 3);
#define SB() __builtin_amdgcn_sched_barrier(0)
#define PV_RD(x, off) asm volatile("ds_read_b64_tr_b16 %0, %1 offset:%2" : "=v"(x) : "v"(va), "n"(off))
#define PV_LD(l0, h0, l1, h1, g) do { PV_RD(l0, ((g) >> 1) * 1024 + (2 * ((g) & 1)) * 4096); PV_RD(h0, ((g) >> 1) * 1024 + 512 + (2 * ((g) & 1)) * 4096); \
                                      PV_RD(l1, ((g) >> 1) * 1024 + (2 * ((g) & 1) + 1) * 4096); PV_RD(h1, ((g) >> 1) * 1024 + 512 + (2 * ((g) & 1) + 1) * 4096); } while (0)
#define PV_WT(n, l0, h0, l1, h1) asm volatile("s_waitcnt lgkmcnt(" #n ")" : "+v"(l0), "+v"(h0), "+v"(l1), "+v"(h1))
#define PV_M0(l0, h0, g) O[2 * ((g) & 1)] = __builtin_amdgcn_mfma_f32_32x32x16_bf16((bf16x8){l0[0], l0[1], l0[2], l0[3], h0[0], h0[1], h0[2], h0[3]}, pf[(g) >> 1], O[2 * ((g) & 1)], 0, 0, 0)
#define PV_M1(l1, h1, g) O[2 * ((g) & 1) + 1] = __builtin_amdgcn_mfma_f32_32x32x16_bf16((bf16x8){l1[0], l1[1], l1[2], l1[3], h1[0], h1[1], h1[2], h1[3]}, pf[(g) >> 1], O[2 * ((g) & 1) + 1], 0, 0, 0)
#define SM_E2(c) do { float s0 = S[(c) >> 3][2 * ((c) & 7)], s1 = S[(c) >> 3][2 * ((c) & 7) + 1]; asm volatile("" : "+v"(s0), "+v"(s1)); \
                      float p0 = __builtin_amdgcn_exp2f(s0), p1 = __builtin_amdgcn_exp2f(s1); ls += p0; ls += p1; asm volatile("" : "+v"(p0), "+v"(p1), "+v"(ls)); \
                      S[(c) >> 3][2 * ((c) & 7)] = p0; S[(c) >> 3][2 * ((c) & 7) + 1] = p1; } while (0)
#define SM_PKH(k, h) do { u32x2 pw; pw.x = pk2(S[(k) >> 1][8 * ((k) & 1) + 4 * (h) + 0], S[(k) >> 1][8 * ((k) & 1) + 4 * (h) + 1]); pw.y = pk2(S[(k) >> 1][8 * ((k) & 1) + 4 * (h) + 2], S[(k) >> 1][8 * ((k) & 1) + 4 * (h) + 3]); \
                            asm volatile("" : "+v"(pw.x), "+v"(pw.y)); u32x4 w_ = __builtin_bit_cast(u32x4, pf[k]); w_[2 * (h)] = pw.x; w_[2 * (h) + 1] = pw.y; pf[k] = __builtin_bit_cast(bf16x8, w_); } while (0)
    const unsigned va = (unsigned)(size_t)vp;
    s16x4 la0, ha0, la1, ha1, lb0, hb0, lb1, hb1;
    PV_LD(la0, ha0, la1, ha1, 0); SB();
    PV_LD(lb0, hb0, lb1, hb1, 1); SB(); PV_WT(4, la0, ha0, la1, ha1); PV_M0(la0, ha0, 0); SB(); SM_E2(0); SB(); PV_M1(la1, ha1, 0); SB(); SM_E2(1); SB();
    PV_LD(la0, ha0, la1, ha1, 2); SB(); PV_WT(4, lb0, hb0, lb1, hb1); PV_M0(lb0, hb0, 1); SB(); SM_E2(2); SB(); PV_M1(lb1, hb1, 1); SB(); SM_E2(3); SB();
    PV_LD(lb0, hb0, lb1, hb1, 3); SB(); PV_WT(4, la0, ha0, la1, ha1); PV_M0(la0, ha0, 2); SB(); SM_E2(4); SM_PKH(0, 0); SB(); PV_M1(la1, ha1, 2); SB(); SM_E2(5); SM_PKH(0, 1); SB();
    PV_LD(la0, ha0, la1, ha1, 4); SB(); PV_WT(4, lb0, hb0, lb1, hb1); PV_M0(lb0, hb0, 3); SB(); SM_E2(6); SB(); PV_M1(lb1, hb1, 3); SB(); SM_E2(7); SB();
    PV_LD(lb0, hb0, lb1, hb1, 5); SB(); PV_WT(4, la0, ha0, la1, ha1); PV_M0(la0, ha0, 4); SB(); SM_E2(8); SM_PKH(1, 0); SB(); PV_M1(la1, ha1, 4); SB(); SM_E2(9); SM_PKH(1, 1); SB();
    PV_LD(la0, ha0, la1, ha1, 6); SB(); PV_WT(4, lb0, hb0, lb1, hb1); PV_M0(lb0, hb0, 5); SB(); SM_E2(10); SB(); PV_M1(lb1, hb1, 5); SB(); SM_E2(11); SB();
    PV_LD(lb0, hb0, lb1, hb1, 7); SB(); PV_WT(4, la0, ha0, la1, ha1); PV_M0(la0, ha0, 6); SB(); SM_E2(12); SM_PKH(2, 0); SB(); PV_M1(la1, ha1, 6); SB(); SM_E2(13); SM_PKH(2, 1); SB();
    PV_WT(0, lb0, hb0, lb1, hb1); PV_M0(lb0, hb0, 7); SB(); SM_E2(14); SB(); PV_M1(lb1, hb1, 7); SB(); SM_E2(15); SB();
    SM_PKH(3, 0); SM_PKH(3, 1);
#undef PV_RD
#undef PV_LD
#undef PV_WT
#undef PV_M0
#undef PV_M1
#undef SM_E2
#undef SM_PKH
#undef SB
}
__device__ __forceinline__ void y_store(float* yp, const f32x16 (&O)[4], float f) {
#pragma unroll
    for (int db = 0; db < 4; ++db)
#pragma unroll
        for (int i = 0; i < 4; ++i) { f32x4 v; v[0] = O[db][4 * i] * f; v[1] = O[db][4 * i + 1] * f; v[2] = O[db][4 * i + 2] * f; v[3] = O[db][4 * i + 3] * f; *(f32x4*)(yp + 32 * db + 8 * i) = v; }
}

#define NSA_WAITN(n) do { const int _n = (n); if (_n >= 4) NSA_WAIT(4); else if (_n >= 2) NSA_WAIT(2); else NSA_WAIT(0); } while (0)
template <bool WIN> __device__ __forceinline__ void online_branch(const Frame& F, int tid, NLAS char* L, const bf16x8 (&qf)[8], f32x16 (&O)[4], float& l_out,
        const char* kg, const char* vg, const NLAS int* tl, int nt, int t, float sl2, int cur, const NLAS unsigned* selq) {
    const int lane = tid & 63, hf = lane >> 5, wave = F.wave;
    float m = 0.f, l = 0.f;
#pragma unroll
    for (int db = 0; db < 4; ++db)
#pragma unroll
        for (int r = 0; r < 16; ++r) O[db][r] = 0.f;
#define NSA_BEHIND(i) (2 * (((i) + 1 < nt ? 1 : 0) + ((i) < nt ? 1 : 0)))
    { const int j0 = tl[0]; dma_k(kg + (size_t)j0 * 64 * 512, 512, L, wave, lane);
      if (nt > 1) { const int j1 = tl[1]; dma_k(kg + (size_t)j1 * 64 * 512, 512, L + STG, wave, lane); }
      dma_v(vg + (size_t)j0 * 64 * 512, 512, L + KIMG, wave, lane); }
    int s_i = 0, s_im1 = 2 * STG;
    bf16x8 pf[4]; f32x16 S[2];
#define NSA_SCORES(i, alpha) do { \
        const int j = tl[i]; \
        bool colsel = true; \
        if (!WIN) { const unsigned w = selq[j >> 5]; colsel = (w >> (j & 31)) & 1u; } \
        const int dbase = t - 64 * j - 4 * hf; \
        const float base2 = colsel ? -sl2 * (float)dbase - m : NEG;     \
        qk_tile(S, L + s_i, qf, base2, sl2, lane); \
        const bool need_mask = WIN ? (j == cur || j == cur - 8) : (j == cur); \
        if (__builtin_amdgcn_readfirstlane((int)need_mask)) { asm volatile("" : "+v"(S[0]), "+v"(S[1])); mask_tile(S, dbase, 1, WIN ? 512u : 0x7fffffffu); }     \
        const float mx = tile_max(S); \
          \
        if ((i) == 0 || __any(mx > RESC_THR)) { const float dl = (i) == 0 ? (mx > -1.0e29f ? mx : 0.f) : fmaxf(mx, 0.f);     \
            alpha = (i) == 0 ? 1.0f : __builtin_amdgcn_exp2f(-dl); l *= alpha; m += dl; \
            _Pragma("unroll") for (int kb2 = 0; kb2 < 2; ++kb2) _Pragma("unroll") for (int r = 0; r < 16; ++r) S[kb2][r] -= dl; } \
    } while (0)
#define NSA_TOP(i) do { NSA_WAITN(NSA_BEHIND(i)); NSA_BAR(); \
        if ((i) + 2 < nt) { const int j2 = tl[(i) + 2]; dma_k(kg + (size_t)j2 * 64 * 512, 512, L + s_im1, wave, lane); }            \
        if ((i) + 1 < nt) { const int j1 = tl[(i) + 1]; dma_v(vg + (size_t)j1 * 64 * 512, 512, L + (s_i == 2 * STG ? 0 : s_i + STG) + KIMG, wave, lane); } } while (0)
#define NSA_ADV() do { const int s_n = s_i == 2 * STG ? 0 : s_i + STG; s_im1 = s_i; s_i = s_n; } while (0)
    {
        NSA_TOP(0);
        float alpha = 1.0f; NSA_SCORES(0, alpha);
        float ls = 0.f;
#pragma unroll
        for (int kb2 = 0; kb2 < 2; ++kb2)
#pragma unroll
            for (int r = 0; r < 16; ++r) { const float p = __builtin_amdgcn_exp2f(S[kb2][r]); S[kb2][r] = p; ls += p; }
        pack_p(pf, S); l += ls;
        NSA_ADV();
    }
    for (int i = 1; i < nt; ++i) {
        NSA_TOP(i);
        float alpha = 1.0f; NSA_SCORES(i, alpha);
        float ls = 0.f;
        pv_sm_tile(O, pf, L + s_im1 + KIMG, lane, S, ls);
        l += ls;
        if (__any(alpha != 1.0f)) {
#pragma unroll
            for (int db = 0; db < 4; ++db)
#pragma unroll
                for (int r = 0; r < 16; ++r) O[db][r] *= alpha; }
        NSA_ADV();
    }
    { NSA_TOP(nt); pv_tile(O, pf, L + s_im1 + KIMG, lane); }
#undef NSA_SCORES
#undef NSA_TOP
#undef NSA_ADV
    NSA_WAIT(0); NSA_BAR();
#undef NSA_BEHIND
    l_out = l + swap_other(l);
}
}

__device__ __forceinline__ void p3_attn(const Frame& F, const Args& A) {
    using namespace nsa;
    NLAS char* L = (NLAS char*)F.lds;
    const int wave = F.wave;
    const bf16* qb = (const bf16*)(F.ws + WS_Q); const char* kvb = (const char*)(F.ws + WS_KV);
    const char* kcb = (const char*)(F.ws + WS_KC); const float* ng = (const float*)(F.ws + WS_NSAG); bf16* ya = (bf16*)(F.ws + WS_YA);
    float* y32a = A.out; float* y32b = (float*)(F.ws + WS_WIN);
    NLAS float* imp = (NLAS float*)(L + L_IMP); NLAS unsigned* selm = (NLAS unsigned*)(L + L_SELM); NLAS unsigned* um = (NLAS unsigned*)(L + L_UM); NLAS int* tl = (NLAS int*)(L + L_TL);
    const int vcu = (F.G % 8 == 0) ? (F.bid % 8) * (F.G / 8) + F.bid / 8 : F.bid;
    for (int item = vcu; item < 256; item += F.G) {
        int tid = F.tid; asm volatile("" : "+v"(tid));
        const int lane = tid & 63, c = lane & 31, hf = lane >> 5, qi = c & 7, hh = c >> 3;
        const int tq = 127 - (item >> 1), g = item & 1, t0 = 64 * tq, cur = tq;
        const int t = t0 + 8 * wave + qi, head = 4 * g + hh;
        const float sl2 = exp2f(-(float)(head + 1)) * LOG2E;
        bf16x8 qf[8];
#pragma unroll
        for (int ks = 0; ks < 8; ++ks) qf[ks] = *(const bf16x8*)(qb + (size_t)t * QW + head * 128 + 16 * ks + 8 * hf);
        const float* gp = ng + (size_t)t * 24 + head * 3;
        const size_t ycol = (size_t)t * QW + head * 128 + 4 * hf;
        asm volatile("s_waitcnt vmcnt(0)" ::: "memory");
        __syncthreads();
        for (int e = tid; e < 64 * IMPS; e += NTHR) imp[e] = 0.f;
        if (tid < 4) um[tid] = 0u;
        const int nvmax = ((t0 + 63 - 31) >> 4) + 1, ntc = (nvmax + 63) >> 6;
        const char* kc = kcb + (size_t)g * 512 * 256; const char* vc = kcb + (size_t)2 * 512 * 256 + (size_t)g * 512 * 256;
        float m = M_INIT, l = 0.f;
        for (int rp = 0; rp < (ATT_DBL == 1 ? 2 : 1); ++rp) {
        m = M_INIT; l = 0.f;
        dma_k(kc, 256, L, wave, lane); if (ntc > 1) dma_k(kc + (size_t)64 * 256, 256, L + STG, wave, lane);
        int s_cur = 0, s_nxt2 = 2 * STG;
        for (int i = 0; i < ntc; ++i) {
            if (i + 1 < ntc) NSA_WAIT(2); else NSA_WAIT(0);
            NSA_BAR();
            if (i + 2 < ntc) dma_k(kc + (size_t)(i + 2) * 64 * 256, 256, L + s_nxt2, wave, lane);
            const int nb = 64 * i; const int dbase = t - 31 - 16 * (nb + 4 * hf);
            f32x16 S[2];
            qk_tile(S, L + s_cur, qf, -sl2 * (float)dbase, sl2 * 16.f, lane);
            if (16 * (nb + 63) + 31 > t0) { asm volatile("" : "+v"(S[0]), "+v"(S[1])); mask_tile(S, dbase, 16, 0x7fffffffu); }
            const float mnew = fmaxf(m, tile_max(S));
            l *= __builtin_amdgcn_exp2f(m - mnew); m = mnew;
            float ls = 0.f;
#pragma unroll
            for (int kb2 = 0; kb2 < 2; ++kb2)
#pragma unroll
                for (int r = 0; r < 16; ++r) ls += __builtin_amdgcn_exp2f(S[kb2][r] - m);
            l += ls;
            s_nxt2 = s_cur; s_cur = (s_cur == 2 * STG) ? 0 : s_cur + STG;
        }
        NSA_WAIT(0); NSA_BAR();
        }
        l += swap_other(l);
        const float inv_l = l > 0.f ? 1.0f / l : 0.f;
        f32x16 O[4];
        for (int rp = 0; rp < (ATT_DBL == 2 ? 2 : 1); ++rp) {
        const bool do_imp = (rp == (ATT_DBL == 2 ? 1 : 0));
#pragma unroll
        for (int db = 0; db < 4; ++db)
#pragma unroll
            for (int r = 0; r < 16; ++r) O[db][r] = 0.f;
        dma_k(kc, 256, L, wave, lane); dma_v(vc, 256, L + KIMG, wave, lane);
        if (ntc > 1) { dma_k(kc + (size_t)64 * 256, 256, L + STG, wave, lane); dma_v(vc + (size_t)64 * 256, 256, L + STG + KIMG, wave, lane); }
        int s_cur = 0, s_nxt2 = 2 * STG;
        for (int i = 0; i < ntc; ++i) {
            if (i + 1 < ntc) NSA_WAIT(4); else NSA_WAIT(0);
            NSA_BAR();
            if (i + 2 < ntc) { dma_k(kc + (size_t)(i + 2) * 64 * 256, 256, L + s_nxt2, wave, lane); dma_v(vc + (size_t)(i + 2) * 64 * 256, 256, L + s_nxt2 + KIMG, wave, lane); }
            const int nb = 64 * i; const int dbase = t - 31 - 16 * (nb + 4 * hf);
            f32x16 S[2];
            qk_tile(S, L + s_cur, qf, -sl2 * (float)dbase - m, sl2 * 16.f, lane);
            if (16 * (nb + 63) + 31 > t0) { asm volatile("" : "+v"(S[0]), "+v"(S[1])); mask_tile(S, dbase, 16, 0x7fffffffu); }
#pragma unroll
            for (int kb2 = 0; kb2 < 2; ++kb2)
#pragma unroll
                for (int r = 0; r < 16; ++r) S[kb2][r] = __builtin_amdgcn_exp2f(S[kb2][r]) * inv_l;
#pragma unroll
            for (int kb2 = 0; kb2 < 2; ++kb2)
#pragma unroll
                for (int i2 = 0; i2 < 4; ++i2) {
                    const float p3 = S[kb2][4 * i2 + 3];
                    float cm = 32.f * ((S[kb2][4 * i2] + S[kb2][4 * i2 + 1]) + S[kb2][4 * i2 + 2]) + 16.f * p3, cn = 16.f * p3;
                    cm += __shfl_xor(cm, 8); cm += __shfl_xor(cm, 16); cn += __shfl_xor(cn, 8); cn += __shfl_xor(cn, 16);
                    if (hh == 0 && do_imp) { const int j = ((nb + 32 * kb2) >> 2) + 2 * i2 + hf; NLAS float* ip = imp + (8 * wave + qi) * IMPS + j; ip[0] += cm; }
                    asm volatile("" ::: "memory");
                    if (hh == 0 && do_imp) { const int j = ((nb + 32 * kb2) >> 2) + 2 * i2 + hf; NLAS float* ip = imp + (8 * wave + qi) * IMPS + j; ip[1] += cn; }
                    asm volatile("" ::: "memory");
                }
            { bf16x8 pf[4]; pack_p(pf, S); pv_tile(O, pf, L + s_cur + KIMG, lane); }
            s_nxt2 = s_cur; s_cur = (s_cur == 2 * STG) ? 0 : s_cur + STG;
        }
        NSA_WAIT(0); NSA_BAR();
        }
        y_store(y32a + ycol, O, gp[0]);
        for (int rp = 0; rp < (ATT_DBL == 3 ? 2 : 1); ++rp) {
            unsigned m0 = 0u, m1 = 0u, m2 = 0u, m3 = 0u; const int q = tid >> 2, part = tid & 3;
            if (wave < 4) {
                unsigned k[32];
#pragma unroll
                for (int i4 = 0; i4 < 8; ++i4) { const f32x4 raw = *(const NLAS f32x4*)(imp + q * IMPS + part * 32 + 4 * i4);
#pragma unroll
                    for (int e = 0; e < 4; ++e) { const int j = part * 32 + 4 * i4 + e; const bool forced = (j == 0) || (j == cur) || (j == cur - 1);
                        const unsigned vb = forced ? 0x49742400u   : __float_as_uint(raw[e]);
                        k[4 * i4 + e] = (j <= cur || forced) ? ((vb & 0xFFFFFF00u) | (unsigned)(255 - j)) : 0u; } }
                unsigned prev = 0xFFFFFFFFu;
                for (int r = 0; r < 16; ++r) {
                    unsigned bk = 0u;
#pragma unroll
                    for (int i = 0; i < 32; ++i) { const unsigned c = k[i] < prev ? k[i] : 0u; bk = c > bk ? c : bk; }
                    { const unsigned o = (unsigned)__builtin_amdgcn_update_dpp(0, (int)bk, 0xB1, 0xF, 0xF, false); bk = o > bk ? o : bk; }
                    { const unsigned o = (unsigned)__builtin_amdgcn_update_dpp(0, (int)bk, 0x4E, 0xF, 0xF, false); bk = o > bk ? o : bk; }
                    prev = bk;
                    if (bk != 0u) { const int bi = 255 - (int)(bk & 0xFFu); const unsigned bit = 1u << (bi & 31); const int w = bi >> 5; m0 |= w == 0 ? bit : 0u; m1 |= w == 1 ? bit : 0u; m2 |= w == 2 ? bit : 0u; m3 |= w == 3 ? bit : 0u; }
                }
                if (part == 0) { selm[q * 4 + 0] = m0; selm[q * 4 + 1] = m1; selm[q * 4 + 2] = m2; selm[q * 4 + 3] = m3;
                    atomicOr((unsigned*)(um + 0), m0); atomicOr((unsigned*)(um + 1), m1); atomicOr((unsigned*)(um + 2), m2); atomicOr((unsigned*)(um + 3), m3); }
            }
        }
        __syncthreads();
        int nts;
        {
            const unsigned u0 = um[0], u1 = um[1], u2 = um[2], u3 = um[3];
            nts = __popc(u0) + __popc(u1) + __popc(u2) + __popc(u3);
            if (tid < 128) { const int w = tid >> 5, b = tid & 31; const unsigned uw = w == 0 ? u0 : w == 1 ? u1 : w == 2 ? u2 : u3;
                if ((uw >> b) & 1u) { int rank = __popc((uw >> b) >> 1); if (w < 3) rank += __popc(u3); if (w < 2) rank += __popc(u2); if (w < 1) rank += __popc(u1); tl[rank] = tid; } }
        }
        asm volatile("s_waitcnt vmcnt(0)" ::: "memory");
        __syncthreads();
        float lb;
        for (int rp = 0; rp < (ATT_DBL == 4 ? 2 : 1); ++rp)
        online_branch<false>(F, tid, L, qf, O, lb, kvb + (size_t)2 * T * 512 + g * 256, kvb + (size_t)3 * T * 512 + g * 256, tl, nts, t, sl2, cur, selm + (8 * wave + qi) * 4);
        y_store(y32b + ycol, O, lb > 0.f ? gp[1] / lb : 0.f);
        const int ntw = cur >= 8 ? 9 : cur + 1;
        if (tid < ntw) tl[tid] = cur - tid;
        asm volatile("s_waitcnt vmcnt(0)" ::: "memory");
        __syncthreads();
        for (int rp = 0; rp < (ATT_DBL == 5 ? 2 : 1); ++rp)
        online_branch<true>(F, tid, L, qf, O, lb, kvb + (size_t)4 * T * 512 + g * 256, kvb + (size_t)5 * T * 512 + g * 256, tl, ntw, t, sl2, cur, selm);
        { const float f = lb > 0.f ? gp[2] / lb : 0.f; const float* pa = y32a + ycol; const float* pb = y32b + ycol; bf16* po = ya + (size_t)t * YLD + head * 128 + 4 * hf;
#pragma unroll
          for (int db = 0; db < 4; ++db)
#pragma unroll
            for (int i = 0; i < 4; ++i) { const f32x4 a = *(const f32x4*)(pa + 32 * db + 8 * i), b = *(const f32x4*)(pb + 32 * db + 8 * i);
                u32x2 w; w.x = pk2(a[0] + b[0] + O[db][4 * i] * f, a[1] + b[1] + O[db][4 * i + 1] * f); w.y = pk2(a[2] + b[2] + O[db][4 * i + 2] * f, a[3] + b[3] + O[db][4 * i + 3] * f);
                *(u32x2*)(po + 32 * db + 8 * i) = w; } }
    }
    __syncthreads();
}

#define XB_ROWCNT(pm) (3584 + 16 * (pm))
struct EpiResNorm {
    static constexpr bool PERM = false, AFTER_DRAIN = false, HAS_MID = false, USES_LDS = false;
    const bf16* xb; float* part; unsigned* bar; const float* fg; float* out;
    __device__ __forceinline__ void operator()(f32x4 (&acc)[2][2][4][2], const Unit& u, int wr, int wc, int fr, int fq) const {
        const int row0 = u.pm * 256 + wr * 64 + fr, col0 = u.pn * 256 + wc * 32 + 4 * fq;
#pragma unroll
        for (int ai = 0; ai < 2; ++ai)
#pragma unroll
            for (int m = 0; m < 4; ++m) { const int row = row0 + ai * 128 + m * 16; const size_t ro = (size_t)row * 2048 + col0; float ss = 0.f;
#pragma unroll
                for (int bj = 0; bj < 2; ++bj)
#pragma unroll
                    for (int n = 0; n < 2; ++n) { const size_t o = ro + bj * 128 + n * 16; const u32x2 xw = *(const u32x2*)(xb + o);
                        f32x4 v = acc[ai][bj][m][n]; v[0] += bflo(xw.x); v[1] += bfhi(xw.x); v[2] += bflo(xw.y); v[3] += bfhi(xw.y);
                        ss += (v[0] * v[0] + v[1] * v[1]) + (v[2] * v[2] + v[3] * v[3]); acc[ai][bj][m][n] = v; }
                ss += __shfl_xor(ss, 16); ss += __shfl_xor(ss, 32);
                if (fq == 0) __hip_atomic_store(part + (size_t)row * 32 + u.pn * 4 + wc, ss, __ATOMIC_RELAXED, __HIP_MEMORY_SCOPE_AGENT); }
        asm volatile("s_waitcnt vmcnt(0)" ::: "memory");
        __syncthreads();
        if (threadIdx.x == 0) { unsigned* c = bar + XB_ROWCNT(u.pm); (void)xb_add(c, 1u); XB_SPIN(xb_ld(c) < 8u, bar); }
        __syncthreads();
        float rs[2][4];
#pragma unroll
        for (int ai = 0; ai < 2; ++ai)
#pragma unroll
            for (int m = 0; m < 4; ++m) { const int row = row0 + ai * 128 + m * 16; const unsigned long long* pp = (const unsigned long long*)(part + (size_t)row * 32 + fq * 8); float ss = 0.f;
#pragma unroll
                for (int i = 0; i < 4; ++i) { const unsigned long long w = __hip_atomic_load(pp + i, __ATOMIC_RELAXED, __HIP_MEMORY_SCOPE_AGENT); ss += __uint_as_float((unsigned)w) + __uint_as_float((unsigned)(w >> 32)); }
                rs[ai][m] = ss; }
#pragma unroll
        for (int ai = 0; ai < 2; ++ai)
#pragma unroll
            for (int m = 0; m < 4; ++m) { float ss = rs[ai][m]; ss += __shfl_xor(ss, 16); ss += __shfl_xor(ss, 32); rs[ai][m] = rsqrtf(ss * (1.0f / DM) + NORM_EPS); }
#pragma unroll
        for (int bj = 0; bj < 2; ++bj)
#pragma unroll
            for (int n = 0; n < 2; ++n) { const f32x4 g4 = *(const f32x4*)(fg + col0 + bj * 128 + n * 16);
#pragma unroll
                for (int ai = 0; ai < 2; ++ai)
#pragma unroll
                    for (int m = 0; m < 4; ++m) { const int row = row0 + ai * 128 + m * 16; const float r = rs[ai][m]; const f32x4 v = acc[ai][bj][m][n];
                        f32x4 o; o[0] = v[0] * r * g4[0]; o[1] = v[1] * r * g4[1]; o[2] = v[2] * r * g4[2]; o[3] = v[3] * r * g4[3];
                        *(f32x4*)(out + (size_t)row * 2048 + col0 + bj * 128 + n * 16) = o; } }
    }
};

__device__ __forceinline__ void p8_final(const Frame& F, const Args& A) {
    const int gw = F.bid * NWAVES + F.wave, NGW = F.G * NWAVES;
    const float* part = (const float*)(F.ws + WS_P3); const float* fg = A.in[21]; const bf16* x3 = (const bf16*)(F.ws + WS_H);
    f32x4 gq[8];
#pragma unroll
    for (int j = 0; j < 4; ++j) { gq[2 * j] = ((const f32x4*)fg)[(F.lane + 64 * j) * 2]; gq[2 * j + 1] = ((const f32x4*)fg)[(F.lane + 64 * j) * 2 + 1]; }
    for (int m0 = gw; m0 < T; m0 += 2 * NGW) {
        const int m1 = m0 + NGW; const bool has1 = m1 < T; const int m1c = has1 ? m1 : m0;
        const float s0 = F.lane < 32 ? part[(size_t)m0 * 32 + F.lane] : 0.f, s1 = F.lane < 32 ? part[(size_t)m1c * 32 + F.lane] : 0.f;
        u32x4 w0[4], w1[4];
#pragma unroll
        for (int j = 0; j < 4; ++j) { w0[j] = ((const u32x4*)(x3 + (size_t)m0 * DM))[F.lane + 64 * j]; w1[j] = ((const u32x4*)(x3 + (size_t)m1c * DM))[F.lane + 64 * j]; }
        const float r0 = rsqrtf(wave_sum(s0) * (1.0f / DM) + NORM_EPS), r1 = rsqrtf(wave_sum(s1) * (1.0f / DM) + NORM_EPS);
#pragma unroll
        for (int rr = 0; rr < 2; ++rr) { if (rr == 1 && !has1) break; const float r = rr ? r1 : r0; f32x4* orow = (f32x4*)(A.out + (size_t)(rr ? m1 : m0) * DM);
#pragma unroll
            for (int j = 0; j < 4; ++j) { const u32x4 w = rr ? w1[j] : w0[j]; const int c4 = (F.lane + 64 * j) * 2; const f32x4 g0 = gq[2 * j], g1 = gq[2 * j + 1];
                f32x4 o0, o1; o0[0] = bflo(w.x) * r * g0[0]; o0[1] = bfhi(w.x) * r * g0[1]; o0[2] = bflo(w.y) * r * g0[2]; o0[3] = bfhi(w.y) * r * g0[3];
                o1[0] = bflo(w.z) * r * g1[0]; o1[1] = bfhi(w.z) * r * g1[1]; o1[2] = bflo(w.w) * r * g1[2]; o1[3] = bfhi(w.w) * r * g1[3];
                orow[c4] = o0; orow[c4 + 1] = o1; } }
    }
}

constexpr int NPHASE = 10;
__global__ void __launch_bounds__(NTHR, 2) mega_fwd(Args args) {
    extern __shared__ __attribute__((aligned(16))) unsigned char lds[];
    cg::grid_group grid = cg::this_grid();
    Frame F; F.lds = lds; F.tid = threadIdx.x; F.lane = F.tid & 63; F.wave = __builtin_amdgcn_readfirstlane(F.tid >> 6); F.G = gridDim.x; F.bid = blockIdx.x; F.ws = args.ws;
    PG8_LAS unsigned char* lds3 = (PG8_LAS unsigned char*)lds;
    const int lo = args.ph_lo, hi = args.ph_hi;
    volatile __attribute__((address_space(3))) unsigned* xst = (volatile __attribute__((address_space(3))) unsigned*)(lds3 + LDS_BYTES - 16);
    if (F.tid == 0) { xst[0] = 0u; xst[1] = 0u; }
    __syncthreads();
    if (MK_ONE_LAUNCH && GSYNC_SEAM == 0 && F.bid == 0) { unsigned* bw = (unsigned*)(args.ws + WS_BAR); for (int e = F.tid; e < 4096; e += NTHR) bw[e] = 0u; }
    XcdBarrier xbar; xbar.bar = (unsigned*)(args.ws + WS_BAR); xbar.x = 0; xbar.st = xst;
    if (MK_ONE_LAUNCH && GSYNC_SEAM != 0) xbar = xcd_barrier_post((unsigned*)(args.ws + WS_BAR), xst);
#define IN(k) (lo <= (k) && (k) < hi)
#define SEAM(k) do { if (IN(k) && IN((k) + 1)) { if ((k) == GSYNC_SEAM) grid.sync(); else xcd_barrier(xbar); } } while (0)
    unsigned char* ws = args.ws;
#define PH0 { p0_prologue(F, args); if (!FILL_FFN_IN_P1) convert_wffn(F, args, F.bid, F.G); if (!FILL_DOWN_IN_P6) convert_wdown(F, args, F.bid, F.G); }
#define PH1 { pg8::Gemm g{(const bf16*)(ws + WS_H), (const bf16*)(ws + WS_WIN), T, NP0M, DM, DM}; pg8::StaticOrder S; S.init(T, NP0M, F.G, F.bid); S.wgm = WGM_BIG; \
        Epi0 E{ws, 0}; pg8::gemm_phase<Epi0, pg8::StaticOrder, true, true>(lds3, g, S, E); }
#define PH2 { const int gt = F.G >= 256 ? 96 : F.G; \
        if (F.bid < gt) { pg8::Gemm g{(const bf16*)(ws + WS_H), (const bf16*)(ws + WS_WIN) + (size_t)NP0M * DM, T, NP0 - NP0M, DM, DM}; pg8::StaticOrder S; S.init(T, NP0 - NP0M, gt, F.bid); \
            Epi0 E{ws, NP0M / 256}; pg8::gemm_phase<Epi0, pg8::StaticOrder, true, true>(lds3, g, S, E); } \
        __syncthreads(); p2_phase(F, args, F.G >= 256 ? 96 : 0); }
#define PH3 { p3_attn(F, args); \
        const int vcu3 = (F.G % 8 == 0) ? (F.bid % 8) * (F.G / 8) + F.bid / 8 : F.bid;     \
        int it = F.G >= 256 ? SGU_EARLY + (vcu3 - 192) : SGU_EARLY + F.bid; const int step = F.G >= 256 ? 512 : F.G; \
        if (it >= SGU_EARLY) for (; it < 512; it += step) p2::sgu_item(F, args, it); }
#define PH4 { pg8::Gemm g{(const bf16*)(ws + WS_YA), (const bf16*)(ws + WS_WPA), T, DM, 1024, DM}; pg8::MixOrder S; S.init(T, DM, F.G, F.bid); S.wgm = WGM_MIX; \
        EpiMix E{(const bf16*)(ws + WS_GA), (const bf16*)(ws + WS_GB), (bf16*)(ws + WS_MIXED)}; pg8::gemm_phase<EpiMix, pg8::MixOrder, true, true>(lds3, g, S, E); }
#define PH5 { pg8::Gemm g{(const bf16*)(ws + WS_MIXED), (const bf16*)(ws + WS_WOUT), T, DM, DM, DM}; pg8::StaticOrder S; S.init(T, DM, F.G, F.bid); S.wgm = WGM_MIX; \
        EpiRes E{args.in[0], nullptr, (bf16*)(ws + WS_H), (float*)(ws + WS_P2)}; pg8::gemm_phase<EpiRes, pg8::StaticOrder, true, true>(lds3, g, S, E); }
#define PH6 { pg8::Gemm g{(const bf16*)(ws + WS_H), (const bf16*)(ws + WS_WFFN), T, 2 * DFF, DM, DM}; pg8::FfnOrder S; S.init_tiles(34, 43, F.G, F.bid); S.wgm = WGM_BIG; \
        EpiFfnConv E{(const float*)(ws + WS_P2), args.in[18], args.in[19], (bf16*)(ws + WS_G)}; pg8::gemm_phase<EpiFfnConv, pg8::FfnOrder, true, true>(lds3, g, S, E); \
        if (FILL_DOWN_IN_P6) { const int rem = S.nwg % F.G; if (rem != 0 && F.bid >= rem) convert_wdown(F, args, F.bid - rem, F.G - rem); else if (rem == 0) convert_wdown(F, args, F.bid, F.G); } }
#define PH7 { pg8::Gemm g{(const bf16*)(ws + WS_G), (const bf16*)(ws + WS_WDOWN), T, DM, DFF, 64, (size_t)T * 128, (size_t)DM * 128};     pg8::StaticOrder S; S.init(T, DM, F.G, F.bid); \
        if (FUSE78) { EpiResNorm E{(const bf16*)(ws + WS_H), (float*)(ws + WS_P3), (unsigned*)(ws + WS_BAR), args.in[21], args.out}; pg8::gemm_phase<EpiResNorm, pg8::StaticOrder, true, true>(lds3, g, S, E); } \
        else { EpiResB E{(bf16*)(ws + WS_H), (float*)(ws + WS_P3)}; pg8::gemm_phase<EpiResB, pg8::StaticOrder, true, true>(lds3, g, S, E); } }
#define PH8 { p8_final(F, args); }
    if (IN(0)) PH0
#if DBL_PHASE == 0
    grid.sync(); PH0
#endif
    SEAM(0);
    if (MK_ONE_LAUNCH && GSYNC_SEAM == 0) xbar = xcd_barrier_post((unsigned*)(args.ws + WS_BAR), xst);
    if (IN(1)) PH1
#if DBL_PHASE == 1
    grid.sync(); PH1
#endif
    SEAM(1);
    if (IN(2)) PH2
#if DBL_PHASE == 2
    grid.sync(); PH2
#endif
    SEAM(2);
    if (IN(3)) PH3
#if DBL_PHASE == 3
    grid.sync(); PH3
#endif
    SEAM(3);
    if (IN(4)) PH4
#if DBL_PHASE == 4
    grid.sync(); PH4
#endif
    SEAM(4);
    if (IN(5)) PH5
#if DBL_PHASE == 5
    grid.sync(); PH5
#endif
    SEAM(5);
    if (IN(6)) PH6
#if DBL_PHASE == 6
    grid.sync(); PH6
#endif
    SEAM(6);
    const bool FUSE78 = MK_ONE_LAUNCH && F.G >= 256;
    if (IN(7)) PH7
    if (!FUSE78) { SEAM(7);
    if (IN(8)) PH8 }
#if DBL_PHASE == 200
    xcd_barrier(xbar);
    PH0 xcd_barrier(xbar); PH1 xcd_barrier(xbar); PH2 xcd_barrier(xbar); PH3 xcd_barrier(xbar); PH4 xcd_barrier(xbar); PH5 xcd_barrier(xbar); PH6 xcd_barrier(xbar); PH7 xcd_barrier(xbar); PH8
#endif
    if (DBL_PHASE == 100) { for (int i = 0; i < 10; ++i) grid.sync(); }
    if (DBL_PHASE == 101) { for (int i = 0; i < 10; ++i) xcd_barrier(xbar); }
#undef IN
#undef SEAM
}

extern "C" void kernel_launch(void* const* d_in, const int* in_sizes, int n_in, void* d_out, int out_size, void* d_ws, size_t ws_size, hipStream_t stream) {
    static int grid = 0;
    if (grid == 0) {
        if (n_in != 22 || in_sizes[0] != T * DM || out_size != T * DM || ws_size < WS_END) {
            fprintf(stderr, "kernel_launch: unexpected problem (n_in %d, in0 %d, out %d, ws %zu, need %zu)\n", n_in, n_in > 0 ? in_sizes[0] : -1, out_size, ws_size, (size_t)WS_END); grid = -1; return; }
        int dev = 0, cus = 0, per_cu = 0;
        hipGetDevice(&dev); hipDeviceGetAttribute(&cus, hipDeviceAttributeMultiprocessorCount, dev);
        hipFuncSetAttribute((const void*)mega_fwd, hipFuncAttributeMaxDynamicSharedMemorySize, LDS_BYTES);
        hipOccupancyMaxActiveBlocksPerMultiprocessor(&per_cu, (const void*)mega_fwd, NTHR, LDS_BYTES);
        (void)hipGetLastError();
        if (per_cu < 1) { fprintf(stderr, "kernel_launch: occupancy query says %d blocks per CU\n", per_cu); grid = -1; return; }
        grid = cus;
    }
    if (grid < 0) return;
    if (MK_ONE_LAUNCH && GSYNC_SEAM != 0) (void)hipMemsetAsync((char*)d_ws + WS_BAR, 0, 16384, stream);
    Args a{};
    for (int i = 0; i < 22; ++i) a.in[i] = (const float*)d_in[i];
    a.out = (float*)d_out; a.ws = (unsigned char*)d_ws;
#if MK_ONE_LAUNCH
    a.ph_lo = 0; a.ph_hi = NPHASE;
    void* kargs[] = {&a};
    hipError_t e = hipLaunchCooperativeKernel((const void*)mega_fwd, dim3(grid), dim3(NTHR), kargs, LDS_BYTES, stream);
    if (e != hipSuccess) fprintf(stderr, "cooperative launch failed: %s (grid %d)\n", hipGetErrorString(e), grid);
#else
    for (int p = 0; p <= 8; ++p) {
        a.ph_lo = p; a.ph_hi = p + 1;
        hipLaunchKernelGGL(mega_fwd, dim3(grid), dim3(NTHR), LDS_BYTES, stream, a);
    }
#endif
}
```

```cpp
#include <hip/hip_runtime.h>
#include <hip/hip_cooperative_groups.h>
#include <cstdio>
#include <cstdint>
namespace cg = cooperative_groups;

#ifndef MK_ONE_LAUNCH
#define MK_ONE_LAUNCH 1
#endif
#ifndef DBL_PHASE
#define DBL_PHASE -1
#endif
#ifndef FILL_FFN_IN_P1
#define FILL_FFN_IN_P1 0
#endif
#ifndef FILL_DOWN_IN_P6
#define FILL_DOWN_IN_P6 1
#endif
#ifndef ATT_DBL
#define ATT_DBL 0
#endif
#ifndef GSYNC_SEAM
#define GSYNC_SEAM -1
#endif
#ifndef WGM_BIG
#define WGM_BIG 4
#endif
#ifndef WGM_MIX
#define WGM_MIX 4
#endif

namespace pg8 {
#define PG8_LAS __attribute__((address_space(3)))
typedef unsigned short bf16_t;
typedef short bf16x8 __attribute__((ext_vector_type(8)));
typedef float f32x4 __attribute__((ext_vector_type(4)));
typedef unsigned u32x4 __attribute__((ext_vector_type(4)));
typedef unsigned u32x2 __attribute__((ext_vector_type(2)));
constexpr int BM = 256, BK = 64, HALF = 128, HTB = HALF * BK * 2, STAGE_BYTES = 8 * HTB, NXCD = 8, WGM = 8;

__host__ __device__ __forceinline__ int lds_byte(int r, int c) { const int st = (r >> 4) * 2 + (c >> 5), rr = r & 15, cc = c & 31, ob = rr * 64 + cc * 2; return st * 1024 + (ob ^ (((ob >> 9) & 1) << 5)); }
__host__ __device__ __forceinline__ void stage_rc(int b, int& R, int& C) { const int st = b / 1024, sb = b % 1024, swz = sb ^ (((sb >> 9) & 1) << 5); R = (st >> 1) * 16 + swz / 64; C = (st & 1) * 32 + (swz % 64) / 2; }
__host__ __device__ __forceinline__ int perm32(int rho) { const int n = rho >> 4, i = rho & 15; return 8 * (i >> 2) + 4 * n + (i & 3); }

struct Unit { int pm, pn, kh; };
struct Gemm { const bf16_t* A; const bf16_t* Bt; int M, N, K, ld; size_t ksa = 0, ksb = 0; };

struct StaticOrder {
    int nM, nN, nwg, G, c, wgm = WGM;
    __host__ __device__ void init(int M, int N, int G_, int c_) { nM = M / BM; nN = N / BM; nwg = nM * nN; G = G_; c = c_; }
    __host__ __device__ bool next(int i, Unit& u) const {
        const long L = (long)i * G + c; if (L >= nwg) return false;
        int wgid = (int)L; { const int q = nwg / NXCD, r = nwg % NXCD, xcd = wgid % NXCD, off = wgid / NXCD; wgid = (xcd < r ? xcd * (q + 1) : r * (q + 1) + (xcd - r) * q) + off; }
        const int nig = wgm * nN, gid = wgid / nig, fm = gid * wgm, gsz = (nM - fm) < wgm ? (nM - fm) : wgm;
        u.pm = fm + ((wgid % nig) % gsz); u.pn = (wgid % nig) / gsz; u.kh = 0; return true;
    }
    __device__ __forceinline__ void a_ready(const Unit&) const {}
    __device__ __forceinline__ void done(const Unit&) const {}
    __host__ __device__ __forceinline__ int arow(int pm) const { return pm * BM; }
    __host__ __device__ __forceinline__ int amap(int R) const { return R; }
    __host__ __device__ __forceinline__ int ahrows() const { return HALF; }
};
struct MixOrder : StaticOrder {
    __host__ __device__ bool next(int i, Unit& u) const { if (!StaticOrder::next(i >> 1, u)) return false; u.kh = i & 1; return true; }
};
struct FfnOrder : StaticOrder {
    __host__ __device__ void init_tiles(int nM_, int nN_, int G_, int c_) { nM = nM_; nN = nN_; nwg = nM * nN; G = G_; c = c_; }
    __host__ __device__ __forceinline__ int arow(int pm) const { return 248 * pm - 2; }
    __host__ __device__ __forceinline__ int amap(int R) const { return R - 2 * (R >> 6); }
    __host__ __device__ __forceinline__ int ahrows() const { return 124; }
};

typedef float f32x2_cv __attribute__((ext_vector_type(2))); typedef __bf16 bf16x2_cv __attribute__((ext_vector_type(2)));
__device__ __forceinline__ unsigned cvt_pk_bf16(float lo, float hi) { const f32x2_cv v = {lo, hi}; const bf16x2_cv b = __builtin_convertvector(v, bf16x2_cv); return __builtin_bit_cast(unsigned, b); }

template <class Epi, class Sched, bool ALIGN_EPI = false, bool SP2 = false>
__device__ __forceinline__ void gemm_phase(PG8_LAS unsigned char* lds, const Gemm g, const Sched& S, const Epi& E) {
    const int tid = threadIdx.x, wid = __builtin_amdgcn_readfirstlane(tid >> 6), lane = tid & 63, wr = wid >> 2, wc = wid & 3, fr = lane & 15, fq = lane >> 4;
    const int K = g.K, nt = K / BK;
    unsigned voffA[2], voffB[2];
#pragma unroll
    for (int i = 0; i < 2; ++i) { int R, C; stage_rc(tid * 16 + i * 8192, R, C); const int Rb = Epi::PERM ? ((R & ~31) + perm32(R & 31)) : R;
        voffA[i] = (unsigned)(S.amap(R) * g.ld + C) * 2u; voffB[i] = (unsigned)(Rb * g.ld + C) * 2u; }
    const size_t kstepA = g.ksa ? g.ksa : (size_t)(BK * 2), kstepB = g.ksb ? g.ksb : (size_t)(BK * 2);
    const size_t hstep = (size_t)HALF * g.ld * 2, hstepA = (size_t)S.ahrows() * g.ld * 2;
    const size_t tstep = 2 * hstep;
    const unsigned ldsw = (unsigned)wid * 1024u;
    const int aoff = lds_byte(wr * 64 + fr, fq * 8), boff = lds_byte(wc * 32 + fr, fq * 8);
#define PG8_SA(b, h) (((b) * 2 + (h)) * HTB)
#define PG8_SB(b, h) ((4 + (b) * 2 + (h)) * HTB)
#define PG8_STAGE(bufoff, gbase, voff) do { _Pragma("unroll") for (int _i = 0; _i < 2; ++_i) \
        __builtin_amdgcn_global_load_lds((const unsigned*)((const char*)(gbase) + (voff)[_i]), (PG8_LAS unsigned*)(lds + (bufoff) + ldsw + _i * 8192), 16, 0, 0); } while (0)
#define PG8_LDA(dst, b, h) do { _Pragma("unroll") for (int m = 0; m < 4; ++m) _Pragma("unroll") for (int k = 0; k < 2; ++k) dst[m][k] = *(const PG8_LAS bf16x8*)(lds + PG8_SA(b, h) + aoff + m * 2048 + k * 1024); } while (0)
#define PG8_LDB(dst, b, h) do { _Pragma("unroll") for (int n = 0; n < 2; ++n) _Pragma("unroll") for (int k = 0; k < 2; ++k) dst[n][k] = *(const PG8_LAS bf16x8*)(lds + PG8_SB(b, h) + boff + n * 2048 + k * 1024); } while (0)
#define PG8_MMA(ai, bj, At, Bt) do { __builtin_amdgcn_s_setprio(1); _Pragma("unroll") for (int m = 0; m < 4; ++m) _Pragma("unroll") for (int n = 0; n < 2; ++n) _Pragma("unroll") for (int k = 0; k < 2; ++k) \
        acc[ai][bj][m][n] = __builtin_amdgcn_mfma_f32_16x16x32_bf16(Bt[n][k], At[m][k], acc[ai][bj][m][n], 0, 0, 0); __builtin_amdgcn_s_setprio(0); } while (0)
#define PG8_WAIT_V(n) asm volatile("s_waitcnt vmcnt(" #n ")" ::: "memory")
#define PG8_WAIT_L(n) asm volatile("s_waitcnt lgkmcnt(" #n ")" ::: "memory")
#define PG8_BAR __builtin_amdgcn_s_barrier()
#define PG8_SCHED __builtin_amdgcn_sched_barrier(0)
    Unit cur, nxt; int ui = 0;
    if (!S.next(0, cur)) return;
    f32x4 acc[2][2][4][2];
#pragma unroll
    for (int a = 0; a < 2; ++a)
#pragma unroll
        for (int b = 0; b < 2; ++b)
#pragma unroll
            for (int m = 0; m < 4; ++m)
#pragma unroll
                for (int n = 0; n < 2; ++n) acc[a][b][m][n] = (f32x4){0.f, 0.f, 0.f, 0.f};
    bf16x8 At[4][2], B0[2][2], B1[2][2];
    const size_t rstep = (size_t)g.ld * 2, khstep = (size_t)K * 2;
    const char* cA = (const char*)g.A + (ptrdiff_t)S.arow(cur.pm) * (ptrdiff_t)rstep + cur.kh * khstep; const char* cB = (const char*)g.Bt + (size_t)cur.pn * tstep + cur.kh * khstep;
    S.a_ready(cur);
    if constexpr (SP2) {
        PG8_STAGE(PG8_SB(0, 0), cB, voffB); PG8_STAGE(PG8_SB(0, 1), cB + hstep, voffB); PG8_STAGE(PG8_SA(0, 0), cA, voffA); PG8_STAGE(PG8_SA(0, 1), cA + hstepA, voffA);
        if (wr == 1) PG8_BAR;
        PG8_WAIT_V(2); PG8_BAR;
        PG8_STAGE(PG8_SB(1, 0), cB + kstepB, voffB); PG8_STAGE(PG8_SA(1, 0), cA + kstepA, voffA); PG8_STAGE(PG8_SB(1, 1), cB + hstep + kstepB, voffB);
        PG8_WAIT_V(6); PG8_BAR;
    } else {
        PG8_STAGE(PG8_SB(0, 0), cB, voffB); PG8_STAGE(PG8_SA(0, 0), cA, voffA); PG8_STAGE(PG8_SB(0, 1), cB + hstep, voffB); PG8_STAGE(PG8_SA(0, 1), cA + hstepA, voffA);
        if (wr == 1) PG8_BAR;
        PG8_WAIT_V(4); PG8_BAR;
        PG8_STAGE(PG8_SB(1, 0), cB + kstepB, voffB); PG8_STAGE(PG8_SA(1, 0), cA + kstepA, voffA); PG8_STAGE(PG8_SB(1, 1), cB + hstep + kstepB, voffB);
        PG8_WAIT_V(6); PG8_BAR;
    }
    for (;;) {
        const bool has_next = S.next(ui + 1, nxt);
        const char* nA = has_next ? (const char*)g.A + (ptrdiff_t)S.arow(nxt.pm) * (ptrdiff_t)rstep + nxt.kh * khstep : cA; const char* nB = has_next ? (const char*)g.Bt + (size_t)nxt.pn * tstep + nxt.kh * khstep : cB;
        for (int t = 0; t < nt; t += 2) {
            const bool last = (t == nt - 2);
            const char* a1 = cA + (size_t)(t + 1) * kstepA;
            const char* a2 = last ? nA : cA + (size_t)(t + 2) * kstepA; const char* b2 = last ? nB : cB + (size_t)(t + 2) * kstepB;
            const char* a3 = a2 + kstepA; const char* b3 = b2 + kstepB;
            if (last && has_next) S.a_ready(nxt);
            if constexpr (SP2) {
            PG8_LDB(B0, 0, 0); PG8_LDB(B1, 0, 1); PG8_SCHED; PG8_LDA(At, 0, 0); PG8_STAGE(PG8_SA(1, 1), a1 + hstepA, voffA);
            PG8_WAIT_V(8); PG8_WAIT_L(0); PG8_BAR; PG8_MMA(0, 0, At, B0); PG8_MMA(0, 1, At, B1); PG8_BAR; PG8_SCHED;
            PG8_LDA(At, 0, 1); PG8_STAGE(PG8_SB(0, 0), b2, voffB); PG8_STAGE(PG8_SB(0, 1), b2 + hstep, voffB); PG8_STAGE(PG8_SA(0, 0), a2, voffA);
            PG8_WAIT_V(8); PG8_WAIT_L(0); PG8_BAR; PG8_MMA(1, 0, At, B0); PG8_MMA(1, 1, At, B1); PG8_BAR; PG8_SCHED;
            PG8_LDB(B0, 1, 0); PG8_LDB(B1, 1, 1); PG8_SCHED; PG8_LDA(At, 1, 0); PG8_STAGE(PG8_SA(0, 1), a2 + hstepA, voffA);
            PG8_WAIT_V(8); PG8_WAIT_L(0); PG8_BAR; PG8_MMA(0, 0, At, B0); PG8_MMA(0, 1, At, B1); PG8_BAR; PG8_SCHED;
            PG8_LDA(At, 1, 1); PG8_STAGE(PG8_SB(1, 0), b3, voffB); PG8_STAGE(PG8_SB(1, 1), b3 + hstep, voffB); PG8_STAGE(PG8_SA(1, 0), a3, voffA);
            PG8_WAIT_V(8); PG8_WAIT_L(0); PG8_BAR; PG8_MMA(1, 0, At, B0); PG8_MMA(1, 1, At, B1); PG8_BAR; PG8_SCHED;
            } else {
            PG8_LDB(B0, 0, 0); PG8_SCHED; PG8_LDA(At, 0, 0); PG8_STAGE(PG8_SA(1, 1), a1 + hstepA, voffA);
            PG8_WAIT_L(8); PG8_BAR; PG8_WAIT_L(0); PG8_MMA(0, 0, At, B0); PG8_BAR; PG8_SCHED;
            PG8_LDB(B1, 0, 1); PG8_STAGE(PG8_SB(0, 0), b2, voffB);
            PG8_BAR; PG8_WAIT_L(0); PG8_MMA(0, 1, At, B1); PG8_BAR;
            PG8_LDA(At, 0, 1); PG8_STAGE(PG8_SA(0, 0), a2, voffA);
            PG8_BAR; PG8_WAIT_L(0); PG8_MMA(1, 0, At, B0); PG8_BAR; PG8_SCHED;
            PG8_STAGE(PG8_SB(0, 1), b2 + hstep, voffB);
            PG8_WAIT_V(6); PG8_BAR; PG8_MMA(1, 1, At, B1); PG8_BAR;
            PG8_LDB(B0, 1, 0); PG8_SCHED; PG8_LDA(At, 1, 0); PG8_STAGE(PG8_SA(0, 1), a2 + hstepA, voffA);
            PG8_WAIT_L(8); PG8_BAR; PG8_WAIT_L(0); PG8_MMA(0, 0, At, B0); PG8_BAR; PG8_SCHED;
            PG8_LDB(B1, 1, 1); PG8_STAGE(PG8_SB(1, 0), b3, voffB);
            PG8_BAR; PG8_WAIT_L(0); PG8_MMA(0, 1, At, B1); PG8_BAR;
            PG8_LDA(At, 1, 1); PG8_STAGE(PG8_SA(1, 0), a3, voffA);
            PG8_BAR; PG8_WAIT_L(0); PG8_MMA(1, 0, At, B0); PG8_BAR; PG8_SCHED;
            PG8_STAGE(PG8_SB(1, 1), b3 + hstep, voffB);
            PG8_WAIT_V(6); PG8_BAR; PG8_MMA(1, 1, At, B1); PG8_BAR;
            }
        }
        if constexpr (ALIGN_EPI) { if (wr == 0) PG8_BAR; }
        if constexpr (Epi::USES_LDS) E(acc, cur, wr, wc, fr, fq, lds, S); else E(acc, cur, wr, wc, fr, fq);
        S.done(cur);
        if (!has_next) break;
        if (!(Epi::HAS_MID && cur.kh == 0)) {
#pragma unroll
        for (int a = 0; a < 2; ++a)
#pragma unroll
            for (int b = 0; b < 2; ++b)
#pragma unroll
                for (int m = 0; m < 4; ++m)
#pragma unroll
                    for (int n = 0; n < 2; ++n) acc[a][b][m][n] = (f32x4){0.f, 0.f, 0.f, 0.f};
        }
        cur = nxt; cA = nA; cB = nB; ++ui;
        if constexpr (ALIGN_EPI) { if (wr == 1) PG8_BAR; }
    }
    PG8_WAIT_V(0);
    if constexpr (!ALIGN_EPI) { if (wr == 0) PG8_BAR; }
    PG8_BAR;
#undef PG8_SA
#undef PG8_SB
#undef PG8_STAGE
#undef PG8_LDA
#undef PG8_LDB
#undef PG8_MMA
#undef PG8_WAIT_V
#undef PG8_WAIT_L
#undef PG8_BAR
#undef PG8_SCHED
}
}

typedef unsigned short bf16;
typedef float f32x4 __attribute__((ext_vector_type(4)));
typedef unsigned u32x4 __attribute__((ext_vector_type(4)));
typedef unsigned u32x2 __attribute__((ext_vector_type(2)));
constexpr int T = 8192, DM = 2048, NH = 8, HD = 128, NKV = 2, QW = 1024, KVW = 256, SGW = 1024, DFF = 5504;
constexpr int INW = 8728, NP0 = 8960, NP0M = 8192;
constexpr int NWAVES = 8, NTHR = 512;
constexpr float NORM_EPS = 1e-6f, LN_EPS = 1e-5f;
constexpr float QSCALE = 0.08838834764831845f * 1.4426950408889634f;
constexpr float LOG2E = 1.4426950408889634f, LN2 = 0.6931471805599453f;

constexpr size_t MiB = 1u << 20;
constexpr size_t WS_WFFN = 0;
constexpr size_t WS_WDOWN = 43 * MiB;
constexpr size_t WS_H = WS_WDOWN + 43 * MiB / 2;
constexpr size_t WS_O = WS_H + 32 * MiB;
constexpr size_t WS_WIN = WS_O;
constexpr size_t WS_Q = WS_WIN + 35 * MiB;
constexpr size_t WS_KV = WS_Q + 16 * MiB;
constexpr size_t WS_U = WS_KV + 24 * MiB;
constexpr size_t WS_V = WS_U + 16 * MiB;
constexpr size_t WS_GA = WS_V + 16 * MiB;
constexpr size_t WS_GB = WS_GA + 32 * MiB;
constexpr size_t WS_NSAG = WS_GB + 32 * MiB;
constexpr size_t WS_A = WS_O;
constexpr size_t WS_B = WS_A + 86 * MiB;
constexpr size_t WS_G = WS_A;
constexpr size_t WS_MIXED = WS_Q;
constexpr size_t WS_TA = WS_U;
constexpr size_t WS_YA = WS_O + 172 * MiB;
constexpr size_t WS_YB = WS_YA + 2048;
constexpr int YLD = 2048;
constexpr size_t WS_WOUT = WS_YA + 32 * MiB;
constexpr size_t WS_WPA = WS_WOUT + 8 * MiB;
constexpr size_t WS_WPB = WS_WPA + 2048;
constexpr size_t WS_KC = WS_WPA + 8 * MiB;
constexpr size_t WS_P2 = WS_KC + 1 * MiB;
constexpr size_t WS_P3 = WS_P2 + 1 * MiB;
constexpr size_t WS_BAR = WS_P3 + 1 * MiB;
constexpr size_t WS_W1T = WS_BAR + 1 * MiB;
constexpr size_t WS_W2T = WS_W1T + 2 * MiB;
constexpr size_t WS_VSTAT = WS_W2T + 1 * MiB;
constexpr size_t WS_END = WS_VSTAT + 1 * MiB;
static_assert(WS_NSAG + (size_t)T * 24 * 4 <= WS_O + 172 * MiB && WS_B + 86 * MiB == WS_O + 172 * MiB, "overlay map");

constexpr int LDS_BYTES = 147456;

__device__ __forceinline__ float bf2f(unsigned short b) { return __uint_as_float(((unsigned)b) << 16); }
__device__ __forceinline__ float bflo(unsigned w) { return __uint_as_float(w << 16); }
__device__ __forceinline__ float bfhi(unsigned w) { return __uint_as_float(w & 0xffff0000u); }
__device__ __forceinline__ unsigned f2bf(float f) { unsigned u = __float_as_uint(f); return (u + 0x7fffu + ((u >> 16) & 1u)) >> 16; }
__device__ __forceinline__ unsigned pk2(float lo, float hi) { return pg8::cvt_pk_bf16(lo, hi); }
__device__ __forceinline__ float gelu_t(float x) {
    const float e = __builtin_amdgcn_exp2f(x * fmaf(x * x, -0.10294324f, -2.3022082f));
    return x * __builtin_amdgcn_rcpf(1.0f + e);
}
__device__ __forceinline__ float sigmoid_f(float x) { return __builtin_amdgcn_rcpf(1.0f + __builtin_amdgcn_exp2f(x * -1.4426950408889634f)); }
__device__ __forceinline__ float wave_sum(float v) {
#pragma unroll
    for (int o = 1; o < 64; o <<= 1) v += __shfl_xor(v, o);
    return v;
}
__device__ __forceinline__ float wave_max(float v) {
#pragma unroll
    for (int o = 1; o < 64; o <<= 1) v = fmaxf(v, __shfl_xor(v, o));
    return v;
}

struct Args {
    const float* in[22];
    float* out;
    unsigned char* ws;
    int ph_lo, ph_hi;
};


#define XB_TMO      128
#define XB_XCNT(j)  (256  + 64 * (j))
#define XB_XSUB(j)  (1280 + 64 * (j))
#define XB_XGEN(j)  (2304 + 64 * (j))
#define XB_TOP      3328
#define XB_TOPGEN   3392
#define XCD_BAR_WORDS 3456
#define XB_SPIN_CAP (1u << 22)
__device__ __forceinline__ unsigned xb_ld(unsigned* p)              { return __hip_atomic_load(p, __ATOMIC_RELAXED, __HIP_MEMORY_SCOPE_AGENT); }
__device__ __forceinline__ unsigned xb_add(unsigned* p, unsigned v) { return __hip_atomic_fetch_add(p, v, __ATOMIC_RELAXED, __HIP_MEMORY_SCOPE_AGENT); }
__device__ __forceinline__ unsigned xb_xcc_id() { return (unsigned)__builtin_amdgcn_s_getreg((3 << 11) | 20) & 0xFu; }
#define XB_SPIN(cond, bar) do { unsigned _sp = 0; while (cond) { __builtin_amdgcn_s_sleep(1); \
    if ((++_sp & 255u) == 0u) { if (xb_ld(&(bar)[XB_TMO])) break; if (_sp > XB_SPIN_CAP) { atomicAdd(&(bar)[XB_TMO], 1u); break; } } } } while (0)
struct XcdBarrier { unsigned* bar; unsigned x; volatile __attribute__((address_space(3))) unsigned* st; };
__device__ __forceinline__ XcdBarrier xcd_barrier_post(unsigned* bar, volatile __attribute__((address_space(3))) unsigned* st) {
    XcdBarrier b; b.bar = bar; b.x = xb_xcc_id(); b.st = st;
    if (threadIdx.x == 0) (void)xb_add(&bar[XB_XCNT(b.x)], 1u);
    return b;
}
__device__ __forceinline__ void xcd_barrier_complete(unsigned* bar, unsigned x, unsigned& nloc, unsigned& nx) {
    const unsigned G = gridDim.x * gridDim.y * gridDim.z;
    unsigned sum, cnt, mine, sp = 0u;
    for (;;) {
        sum = 0u; cnt = 0u; mine = 0u;
#pragma unroll
        for (unsigned j = 0; j < 16; ++j) { const unsigned c = xb_ld(&bar[XB_XCNT(j)]); sum += c; cnt += (c > 0u) ? 1u : 0u; mine = (j == x) ? c : mine; }
        if (sum == G) break;
        __builtin_amdgcn_s_sleep(1);
        if ((++sp & 255u) == 0u) { if (xb_ld(&bar[XB_TMO])) break; if (sp > XB_SPIN_CAP) { atomicAdd(&bar[XB_TMO], 1u); break; } }
    }
    nloc = mine > 0u ? mine : 1u; nx = cnt > 0u ? cnt : 1u;
}
__device__ __forceinline__ void xcd_barrier(const XcdBarrier& b) {
    asm volatile("s_waitcnt vmcnt(0)" ::: "memory");
    __syncthreads();
    if (threadIdx.x == 0) {
        unsigned* bar = b.bar;
        __builtin_amdgcn_s_waitcnt(0);
        unsigned nloc = b.st[0], nx = b.st[1];
        if (nloc == 0u) { xcd_barrier_complete(bar, b.x, nloc, nx); b.st[0] = nloc; b.st[1] = nx; }
        const unsigned old = xb_add(&bar[XB_XSUB(b.x)], 1u);
        const unsigned gen = old / nloc;
        if (old + 1u == (gen + 1u) * nloc) {
            __builtin_amdgcn_fence(__ATOMIC_RELEASE, "agent");
            asm volatile("s_waitcnt vmcnt(0)" ::: "memory");
            const unsigned og = xb_add(&bar[XB_TOP], 1u);
            const unsigned tg = og / nx;
            if (og + 1u == (tg + 1u) * nx) xb_add(&bar[XB_TOPGEN], 1u);
            else XB_SPIN(xb_ld(&bar[XB_TOPGEN]) == tg, bar);
            __builtin_amdgcn_fence(__ATOMIC_ACQUIRE, "agent");
            xb_add(&bar[XB_XGEN(b.x)], 1u);
            asm volatile("s_waitcnt vmcnt(0)" ::: "memory");
        } else {
            XB_SPIN(xb_ld(&bar[XB_XGEN(b.x)]) == gen, bar);
            __builtin_amdgcn_fence(__ATOMIC_ACQUIRE, "agent");
            asm volatile("s_waitcnt vmcnt(0)" ::: "memory");
        }
    }
    __syncthreads();
}

using pg8::Unit;
struct Epi0 {
    static constexpr bool PERM = false, AFTER_DRAIN = false, HAS_MID = false, USES_LDS = false;
    unsigned char* ws; int pn_off;
    template <int ACT> __device__ __forceinline__ void store(const f32x4 (&acc)[2][2][4][2], bf16* base, int ldc, int colbase, const Unit& u, int wr, int wc, int fr, int fq) const {
        const int row0 = u.pm * 256 + wr * 64 + fr, col0 = colbase + wc * 32 + 4 * fq;
#pragma unroll
        for (int ai = 0; ai < 2; ++ai)
#pragma unroll
            for (int m = 0; m < 4; ++m) { bf16* rowp = base + (size_t)(row0 + ai * 128 + m * 16) * ldc + col0;
#pragma unroll
                for (int bj = 0; bj < 2; ++bj)
#pragma unroll
                    for (int n = 0; n < 2; ++n) { f32x4 v = acc[ai][bj][m][n];
                        if (ACT == 0) { v = v * QSCALE; }
                        if (ACT == 2) { v[0] = gelu_t(v[0]); v[1] = gelu_t(v[1]); v[2] = gelu_t(v[2]); v[3] = gelu_t(v[3]); }
                        if (ACT == 3) { v[0] = sigmoid_f(v[0]); v[1] = sigmoid_f(v[1]); v[2] = sigmoid_f(v[2]); v[3] = sigmoid_f(v[3]); }
                        u32x2 w; w.x = pk2(v[0], v[1]); w.y = pk2(v[2], v[3]);
                        *(u32x2*)(rowp + bj * 128 + n * 16) = w; } }
    }
    __device__ __forceinline__ void operator()(const f32x4 (&acc)[2][2][4][2], const Unit& u, int wr, int wc, int fr, int fq) const {
        const int pn = u.pn + pn_off;
        if (pn < 4) store<0>(acc, (bf16*)(ws + WS_Q), 1024, pn * 256, u, wr, wc, fr, fq);
        else if (pn < 6) {
            bf16* base = (bf16*)(ws + WS_KV) + (size_t)(pn - 4) * T * 256; const int row0 = u.pm * 256 + wr * 64 + fr;
#pragma unroll
            for (int ai = 0; ai < 2; ++ai)
#pragma unroll
                for (int m = 0; m < 4; ++m)
#pragma unroll
                    for (int bj = 0; bj < 2; ++bj)
#pragma unroll
                        for (int n = 0; n < 2; ++n) { const f32x4 v = acc[ai][bj][m][n]; u32x2 w; w.x = pk2(v[0], v[1]); w.y = pk2(v[2], v[3]);
                            *(u32x2*)(base + (size_t)bj * T * 128 + (size_t)(row0 + ai * 128 + m * 16) * 128 + wc * 32 + n * 16 + 4 * fq) = w; }
        }
        else if (pn < 10) store<1>(acc, (bf16*)(ws + WS_KV) + (size_t)(pn - 4) * T * 256, 256, 0, u, wr, wc, fr, fq);
        else if (pn < 14) store<2>(acc, (bf16*)(ws + WS_U), 1024, (pn - 10) * 256, u, wr, wc, fr, fq);
        else if (pn < 18) {
            bf16* base = (bf16*)(ws + WS_V); float* vs = (float*)(ws + WS_VSTAT); const int row0 = u.pm * 256 + wr * 64 + fr, col0 = (pn - 14) * 256 + wc * 32 + 4 * fq;
#pragma unroll
            for (int ai = 0; ai < 2; ++ai)
#pragma unroll
                for (int m = 0; m < 4; ++m) { const int row = row0 + ai * 128 + m * 16; bf16* rowp = base + (size_t)row * 1024 + col0; float s1 = 0.f, s2 = 0.f;
#pragma unroll
                    for (int bj = 0; bj < 2; ++bj)
#pragma unroll
                        for (int n = 0; n < 2; ++n) { const f32x4 v = acc[ai][bj][m][n];
                            const float q0 = gelu_t(v[0]), q1 = gelu_t(v[1]), q2 = gelu_t(v[2]), q3 = gelu_t(v[3]);
                            s1 += (q0 + q1) + (q2 + q3); s2 += (q0 * q0 + q1 * q1) + (q2 * q2 + q3 * q3);
                            u32x2 w; w.x = pk2(q0, q1); w.y = pk2(q2, q3); *(u32x2*)(rowp + bj * 128 + n * 16) = w; }
                    s1 += __shfl_xor(s1, 16); s1 += __shfl_xor(s1, 32); s2 += __shfl_xor(s2, 16); s2 += __shfl_xor(s2, 32);
                    if (fq == 0) { float* o = vs + ((size_t)row * 16 + (pn - 14) * 4 + wc) * 2; o[0] = s1; o[1] = s2; }
                    asm volatile("" ::: "memory"); }
        }
        else if (pn < 26) store<3>(acc, (bf16*)(ws + WS_GA), 2048, (pn - 18) * 256, u, wr, wc, fr, fq);
        else if (pn < 31) store<3>(acc, (bf16*)(ws + WS_GB), 2048, (pn - 26) * 256, u, wr, wc, fr, fq);
        else if (pn >= 32) store<3>(acc, (bf16*)(ws + WS_GB), 2048, (pn - 27) * 256, u, wr, wc, fr, fq);
        else {
            float* ng = (float*)(ws + WS_NSAG);
            if (wc == 0) {
                const int row0 = u.pm * 256 + wr * 64 + fr;
#pragma unroll
                for (int ai = 0; ai < 2; ++ai)
#pragma unroll
                    for (int m = 0; m < 4; ++m)
#pragma unroll
                        for (int n = 0; n < 2; ++n) { const int c = 16 * n + 4 * fq;
                            if (c < 24) { f32x4 v = acc[ai][0][m][n]; f32x4 o; o[0] = sigmoid_f(v[0]); o[1] = sigmoid_f(v[1]); o[2] = sigmoid_f(v[2]); o[3] = sigmoid_f(v[3]);
                                *(f32x4*)(ng + (size_t)(row0 + ai * 128 + m * 16) * 24 + c) = o; } }
            }
        }
    }
};
constexpr float GB_MIN = 1.0e-6f;
struct EpiMix {
    static constexpr bool PERM = false, AFTER_DRAIN = false, HAS_MID = true, USES_LDS = false;
    const bf16* ga; const bf16* gb; bf16* out;
    __device__ __forceinline__ void operator()(f32x4 (&acc)[2][2][4][2], const Unit& u, int wr, int wc, int fr, int fq) const {
        const int row0 = u.pm * 256 + wr * 64 + fr, col0 = u.pn * 256 + wc * 32 + 4 * fq;
        if (u.kh == 0) {
#pragma unroll
            for (int ai = 0; ai < 2; ++ai)
#pragma unroll
                for (int m = 0; m < 4; ++m) { const size_t ro = (size_t)(row0 + ai * 128 + m * 16) * 2048 + col0;
#pragma unroll
                    for (int bj = 0; bj < 2; ++bj)
#pragma unroll
                        for (int n = 0; n < 2; ++n) { const size_t o = ro + bj * 128 + n * 16; const u32x2 aw = *(const u32x2*)(ga + o), bw = *(const u32x2*)(gb + o);
                            f32x4 v = acc[ai][bj][m][n];
                            v[0] *= bflo(aw.x) * __builtin_amdgcn_rcpf(fmaxf(bflo(bw.x), GB_MIN)); v[1] *= bfhi(aw.x) * __builtin_amdgcn_rcpf(fmaxf(bfhi(bw.x), GB_MIN));
                            v[2] *= bflo(aw.y) * __builtin_amdgcn_rcpf(fmaxf(bflo(bw.y), GB_MIN)); v[3] *= bfhi(aw.y) * __builtin_amdgcn_rcpf(fmaxf(bfhi(bw.y), GB_MIN));
                            acc[ai][bj][m][n] = v; }
                    asm volatile("" ::: "memory"); }
        } else {
#pragma unroll
            for (int ai = 0; ai < 2; ++ai)
#pragma unroll
                for (int m = 0; m < 4; ++m) { const size_t ro = (size_t)(row0 + ai * 128 + m * 16) * 2048 + col0;
#pragma unroll
                    for (int bj = 0; bj < 2; ++bj)
#pragma unroll
                        for (int n = 0; n < 2; ++n) { const f32x4 v = acc[ai][bj][m][n]; const size_t o = ro + bj * 128 + n * 16;
                            const u32x2 gw = *(const u32x2*)(gb + o);
                            u32x2 w; w.x = pk2(v[0] * fmaxf(bflo(gw.x), GB_MIN), v[1] * fmaxf(bfhi(gw.x), GB_MIN)); w.y = pk2(v[2] * fmaxf(bflo(gw.y), GB_MIN), v[3] * fmaxf(bfhi(gw.y), GB_MIN));
                            *(u32x2*)(out + o) = w; } }
        }
    }
};
struct EpiRes {
    static constexpr bool PERM = false, AFTER_DRAIN = false, HAS_MID = false, USES_LDS = false;
    const float* xi; float* xo; bf16* xb; float* part;
    __device__ __forceinline__ void operator()(const f32x4 (&acc)[2][2][4][2], const Unit& u, int wr, int wc, int fr, int fq) const {
        const int row0 = u.pm * 256 + wr * 64 + fr, col0 = u.pn * 256 + wc * 32 + 4 * fq;
#pragma unroll
        for (int ai = 0; ai < 2; ++ai)
#pragma unroll
            for (int m = 0; m < 4; ++m) { const int row = row0 + ai * 128 + m * 16; const size_t ro = (size_t)row * 2048 + col0; float ss = 0.f;
#pragma unroll
                for (int bj = 0; bj < 2; ++bj)
#pragma unroll
                    for (int n = 0; n < 2; ++n) { const size_t o = ro + bj * 128 + n * 16;
                        const f32x4 v = acc[ai][bj][m][n] + *(const f32x4*)(xi + o);
                        if (xo) *(f32x4*)(xo + o) = v;
                        ss += (v[0] * v[0] + v[1] * v[1]) + (v[2] * v[2] + v[3] * v[3]);
                        if (xb) { u32x2 w; w.x = pk2(v[0], v[1]); w.y = pk2(v[2], v[3]); *(u32x2*)(xb + o) = w; } }
                ss += __shfl_xor(ss, 16); ss += __shfl_xor(ss, 32);
                if (fq == 0) part[(size_t)row * 32 + u.pn * 4 + wc] = ss; }
    }
};
struct EpiResB {
    static constexpr bool PERM = false, AFTER_DRAIN = false, HAS_MID = false, USES_LDS = false;
    bf16* xb; float* part;
    __device__ __forceinline__ void operator()(const f32x4 (&acc)[2][2][4][2], const Unit& u, int wr, int wc, int fr, int fq) const {
        const int row0 = u.pm * 256 + wr * 64 + fr, col0 = u.pn * 256 + wc * 32 + 4 * fq;
#pragma unroll
        for (int ai = 0; ai < 2; ++ai)
#pragma unroll
            for (int m = 0; m < 4; ++m) { const int row = row0 + ai * 128 + m * 16; const size_t ro = (size_t)row * 2048 + col0; float ss = 0.f;
#pragma unroll
                for (int bj = 0; bj < 2; ++bj)
#pragma unroll
                    for (int n = 0; n < 2; ++n) { const size_t o = ro + bj * 128 + n * 16; const u32x2 xw = *(const u32x2*)(xb + o);
                        f32x4 v = acc[ai][bj][m][n]; v[0] += bflo(xw.x); v[1] += bfhi(xw.x); v[2] += bflo(xw.y); v[3] += bfhi(xw.y);
                        ss += (v[0] * v[0] + v[1] * v[1]) + (v[2] * v[2] + v[3] * v[3]);
                        u32x2 w; w.x = pk2(v[0], v[1]); w.y = pk2(v[2], v[3]); *(u32x2*)(xb + o) = w; }
                ss += __shfl_xor(ss, 16); ss += __shfl_xor(ss, 32);
                if (fq == 0) part[(size_t)row * 32 + u.pn * 4 + wc] = ss; }
    }
};
template <int CTRL> __device__ __forceinline__ float dpp_z(float v) { return __uint_as_float((unsigned)__builtin_amdgcn_update_dpp(0, (int)__float_as_uint(v), CTRL, 0xF, 0xF, true)); }
template <int CTRL> __device__ __forceinline__ float dpp_m(float old, float v) { return __uint_as_float((unsigned)__builtin_amdgcn_update_dpp((int)__float_as_uint(old), (int)__float_as_uint(v), CTRL, 0xF, 0xF, false)); }
#define DPP_SHR1 0x111
#define DPP_SHR2 0x112
#define DPP_SHL14 0x10E
#define DPP_SHL15 0x10F
struct EpiFfnConv {
    static constexpr bool PERM = false, AFTER_DRAIN = false, HAS_MID = false, USES_LDS = false;
    const float* part; const float* cw; const float* cb; bf16* gout;
    __device__ __forceinline__ void operator()(f32x4 (&acc)[2][2][4][2], const Unit& u, int wr, int wc, int fr, int fq) const {
        const int jcol0 = u.pn * 128 + wc * 32 + 4 * fq;
        f32x4 w0, w1, w2, bb;
        w0 = *(const f32x4*)(cw + jcol0); w1 = *(const f32x4*)(cw + DFF + jcol0); w2 = *(const f32x4*)(cw + 2 * DFF + jcol0); bb = *(const f32x4*)(cb + jcol0);
#pragma unroll
        for (int ai = 0; ai < 2; ++ai) { const int rbase = 62 * (4 * u.pm + 2 * ai + wr) - 2 + fr;
#pragma unroll
            for (int m = 0; m < 4; ++m) { int row = rbase + 16 * m; row = row < 0 ? 0 : (row > T - 1 ? T - 1 : row);
                const f32x4 p0 = *(const f32x4*)(part + (size_t)row * 32 + fq * 8), p1 = *(const f32x4*)(part + (size_t)row * 32 + fq * 8 + 4);
                float ss = ((p0[0] + p0[1]) + (p0[2] + p0[3])) + ((p1[0] + p1[1]) + (p1[2] + p1[3]));
                ss += __shfl_xor(ss, 16); ss += __shfl_xor(ss, 32);
                const float r = rsqrtf(ss * (1.0f / 2048.0f) + NORM_EPS);
#pragma unroll
                for (int bj = 0; bj < 2; ++bj)
#pragma unroll
                    for (int n = 0; n < 2; ++n) acc[ai][bj][m][n] = acc[ai][bj][m][n] * r; } }
        if (u.pm == 0 && wr == 0 && fr < 2) { acc[0][0][0][0] = (f32x4){0.f, 0.f, 0.f, 0.f}; acc[0][0][0][1] = (f32x4){0.f, 0.f, 0.f, 0.f}; }
#pragma unroll
        for (int n = 0; n < 2; ++n) { const int j = jcol0 + 16 * n;
            if (n == 1) { w0 = *(const f32x4*)(cw + j); w1 = *(const f32x4*)(cw + DFF + j); w2 = *(const f32x4*)(cw + 2 * DFF + j); bb = *(const f32x4*)(cb + j); }
#pragma unroll
            for (int ai = 0; ai < 2; ++ai) { const int rbase = 62 * (4 * u.pm + 2 * ai + wr) - 2 + fr;
#pragma unroll
                for (int m = 0; m < 4; ++m) {
                    const f32x4 cur = acc[ai][0][m][n]; f32x4 o;
#pragma unroll
                    for (int e = 0; e < 4; ++e) {
                        float z1, z2;
                        if (m > 0) { const float pm_ = acc[ai][0][m - 1][n][e]; z1 = dpp_m<DPP_SHR1>(dpp_z<DPP_SHL15>(pm_), cur[e]); z2 = dpp_m<DPP_SHR2>(dpp_z<DPP_SHL14>(pm_), cur[e]); }
                        else { z1 = dpp_z<DPP_SHR1>(cur[e]); z2 = dpp_z<DPP_SHR2>(cur[e]); }
                        const float y = fmaf(w0[e], z2, fmaf(w1[e], z1, fmaf(w2[e], cur[e], bb[e])));
                        o[e] = gelu_t(y) * acc[ai][1][m][n][e];
                    }
                    const int row = rbase + 16 * m;
                    if ((m > 0 || fr >= 2) && row < T) { u32x2 w; w.x = pk2(o[0], o[1]); w.y = pk2(o[2], o[3]); *(u32x2*)(gout + (size_t)(j >> 6) * (T * 64) + (size_t)row * 64 + (j & 63)) = w; }
                }
            }
        }
    }
};

struct Frame {
    unsigned char* lds;
    int tid, lane, wave, G, bid;
    unsigned char* ws;
};

__device__ __forceinline__ void transpose_item(const float* W, int ldw, int c0, int nvalid, const float* gain, bf16* WT, int ldk, int r0, int nblk, float* scr, int item, int lane, int kmul = 1) {
    const int kb = item / nblk, nb = item % nblk, k0 = 64 * kb, n0 = 32 * nb;
    const int nn = lane & 31; const bool ok = (n0 + nn) < nvalid;
    const float* src = W + (size_t)(k0 + (lane >> 5)) * ldw + c0 + n0 + nn;
    float v[32];
#pragma unroll
    for (int i = 0; i < 32; ++i) v[i] = ok ? src[(size_t)(2 * i) * ldw] : 0.f;
#pragma unroll
    for (int i = 0; i < 32; ++i) scr[(2 * i + (lane >> 5)) * 33 + nn] = v[i];
    asm volatile("s_waitcnt lgkmcnt(0)" ::: "memory");
    const int c = lane & 7;
    f32x4 g0 = {1.f, 1.f, 1.f, 1.f}, g1 = g0;
    if (gain) { g0 = *(const f32x4*)(gain + k0 + 8 * c); g1 = *(const f32x4*)(gain + k0 + 8 * c + 4); }
#pragma unroll
    for (int j = 0; j < 4; ++j) { const int n = (lane >> 3) + 8 * j; const float* s = scr + (8 * c) * 33 + n;
        u32x4 o; o.x = pk2(s[0 * 33] * g0[0], s[1 * 33] * g0[1]); o.y = pk2(s[2 * 33] * g0[2], s[3 * 33] * g0[3]); o.z = pk2(s[4 * 33] * g1[0], s[5 * 33] * g1[1]); o.w = pk2(s[6 * 33] * g1[2], s[7 * 33] * g1[3]);
        *(u32x4*)(WT + (size_t)(r0 + n0 + n) * ldk + (size_t)k0 * kmul + 8 * c) = o; }
    asm volatile("s_waitcnt lgkmcnt(0)" ::: "memory");
}
__device__ __forceinline__ void p0_prologue(const Frame& F, const Args& A) {
    float* scr = (float*)(F.lds + F.wave * 16384);
    const int gw = F.bid * NWAVES + F.wave, NGW = F.G * NWAVES;
    unsigned char* ws = F.ws;
    constexpr int I_IN1 = 32 * (2560 / 32), I_IN2 = 32 * (5376 / 32), I_IN3 = 32 * (256 / 32), I_IN4 = 32 * (768 / 32);
    constexpr int I_OUT = 32 * (2048 / 32), I_PA = 16 * (2048 / 32);
    constexpr int I_W1 = 64 * 4, I_W2 = 2 * 4;
    constexpr int NITEMS = I_IN1 + I_IN2 + I_IN3 + I_IN4 + I_OUT + 2 * I_PA + 2 * I_W1 + 2 * I_W2;
    for (int it = gw; it < NITEMS; it += NGW) {
        int r = it;
        if (r < I_IN1) { transpose_item(A.in[2], INW, 0, 2560, A.in[1], (bf16*)(ws + WS_WIN), 2048, 0, 2560 / 32, scr, r, F.lane); continue; } r -= I_IN1;
        if (r < I_IN2) { transpose_item(A.in[2], INW, 2584, 5376, A.in[1], (bf16*)(ws + WS_WIN), 2048, 2560, 5376 / 32, scr, r, F.lane); continue; } r -= I_IN2;
        if (r < I_IN3) { transpose_item(A.in[2], INW, 2560, 24, A.in[1], (bf16*)(ws + WS_WIN), 2048, 7936, 256 / 32, scr, r, F.lane); continue; } r -= I_IN3;
        if (r < I_IN4) { transpose_item(A.in[2], INW, 7960, 768, A.in[1], (bf16*)(ws + WS_WIN), 2048, 8192, 768 / 32, scr, r, F.lane); continue; } r -= I_IN4;
        if (r < I_OUT) { transpose_item(A.in[15], 2048, 0, 2048, nullptr, (bf16*)(ws + WS_WOUT), 2048, 0, 2048 / 32, scr, r, F.lane); continue; } r -= I_OUT;
        if (r < I_PA) { transpose_item(A.in[13], 2048, 0, 2048, nullptr, (bf16*)(ws + WS_WPA), 2048, 0, 2048 / 32, scr, r, F.lane); continue; } r -= I_PA;
        if (r < I_PA) { transpose_item(A.in[14], 2048, 0, 2048, nullptr, (bf16*)(ws + WS_WPB), 2048, 0, 2048 / 32, scr, r, F.lane); continue; } r -= I_PA;
        if (r < I_W1) { transpose_item(A.in[4], 128, 0, 128, nullptr, (bf16*)(ws + WS_W1T), 4096, 0, 4, scr, r, F.lane); continue; } r -= I_W1;
        if (r < I_W1) { transpose_item(A.in[7], 128, 0, 128, nullptr, (bf16*)(ws + WS_W1T) + 128 * 4096, 4096, 0, 4, scr, r, F.lane); continue; } r -= I_W1;
        if (r < I_W2) { transpose_item(A.in[5], 128, 0, 128, nullptr, (bf16*)(ws + WS_W2T), 128, 0, 4, scr, r, F.lane); continue; } r -= I_W2;
        transpose_item(A.in[8], 128, 0, 128, nullptr, (bf16*)(ws + WS_W2T) + 128 * 128, 128, 0, 4, scr, r, F.lane);
    }
    const float* x = A.in[0]; bf16* h = (bf16*)(ws + WS_H);
    for (int m0 = gw; m0 < T; m0 += 2 * NGW) {
        const int m1 = m0 + NGW; const bool has1 = m1 < T; const int m1c = has1 ? m1 : m0;
        const f32x4* xa = (const f32x4*)(x + (size_t)m0 * DM) + F.lane; const f32x4* xb = (const f32x4*)(x + (size_t)m1c * DM) + F.lane;
        f32x4 va[8], vb[8]; float sa = 0.f, sb = 0.f;
#pragma unroll
        for (int j = 0; j < 8; ++j) { va[j] = xa[64 * j]; vb[j] = xb[64 * j]; }
#pragma unroll
        for (int j = 0; j < 8; ++j) { sa += (va[j][0] * va[j][0] + va[j][1] * va[j][1]) + (va[j][2] * va[j][2] + va[j][3] * va[j][3]); sb += (vb[j][0] * vb[j][0] + vb[j][1] * vb[j][1]) + (vb[j][2] * vb[j][2] + vb[j][3] * vb[j][3]); }
        const float ra = rsqrtf(wave_sum(sa) * (1.0f / DM) + NORM_EPS), rb = rsqrtf(wave_sum(sb) * (1.0f / DM) + NORM_EPS);
        u32x2* oa = (u32x2*)(h + (size_t)m0 * DM) + F.lane; u32x2* ob = (u32x2*)(h + (size_t)m1c * DM) + F.lane;
#pragma unroll
        for (int j = 0; j < 8; ++j) { u32x2 w; w.x = pk2(va[j][0] * ra, va[j][1] * ra); w.y = pk2(va[j][2] * ra, va[j][3] * ra); oa[64 * j] = w; }
        if (has1) {
#pragma unroll
            for (int j = 0; j < 8; ++j) { u32x2 w; w.x = pk2(vb[j][0] * rb, vb[j][1] * rb); w.y = pk2(vb[j][2] * rb, vb[j][3] * rb); ob[64 * j] = w; } }
    }
}
__device__ __forceinline__ void convert_wffn(const Frame& F, const Args& A, int slot, int nslots) {
    float* scr = (float*)(F.lds + F.wave * 16384);
    constexpr int I_FFN = 32 * (11008 / 32);
    for (int r = slot * NWAVES + F.wave; r < I_FFN; r += nslots * NWAVES) { const int n0 = 32 * (r % (11008 / 32)); const int csrc = ((n0 >> 7) & 1) * DFF + (n0 >> 8) * 128 + (n0 & 127);
        transpose_item(A.in[17], 2 * DFF, csrc - n0, 2 * DFF, A.in[16], (bf16*)(F.ws + WS_WFFN), 2048, 0, 11008 / 32, scr, r, F.lane); }
}
__device__ __forceinline__ void convert_wdown(const Frame& F, const Args& A, int slot, int nslots) {
    float* scr = (float*)(F.lds + F.wave * 16384);
    constexpr int I_DOWN = (DFF / 64) * (2048 / 32);
    for (int r = slot * NWAVES + F.wave; r < I_DOWN; r += nslots * NWAVES) transpose_item(A.in[20], 2048, 0, 2048, nullptr, (bf16*)(F.ws + WS_WDOWN), 64, 0, 2048 / 32, scr, r, F.lane, 2048);
}

namespace p2 {
#define PLAS __attribute__((address_space(3)))
typedef short bf16x8 __attribute__((ext_vector_type(8)));
typedef short s16x4 __attribute__((ext_vector_type(4)));
typedef float f32x16 __attribute__((ext_vector_type(16)));
__device__ __forceinline__ s16x4 vtr(const PLAS char* p) { return __builtin_bit_cast(s16x4, __builtin_amdgcn_ds_read_tr16_b64_v4i16((PLAS s16x4*)p)); }
__device__ __forceinline__ bf16x8 pack8(const float (&v)[8]) { u32x4 w; w.x = pk2(v[0], v[1]); w.y = pk2(v[2], v[3]); w.z = pk2(v[4], v[5]); w.w = pk2(v[6], v[7]); return __builtin_bit_cast(bf16x8, w); }
__device__ __forceinline__ void unpack8(const u32x4 w, float (&v)[8]) { v[0] = bflo(w.x); v[1] = bfhi(w.x); v[2] = bflo(w.y); v[3] = bfhi(w.y); v[4] = bflo(w.z); v[5] = bfhi(w.z); v[6] = bflo(w.w); v[7] = bfhi(w.w); }
constexpr int CP_STR = 132;
constexpr int CP_HB = 8 * 32 * CP_STR * 4;
__device__ __forceinline__ void compress_item(const Frame& F, const Args& A, int item) {
    PLAS char* L = (PLAS char*)F.lds; const int lane = F.lane, wave = F.wave, c = lane & 31, hf = lane >> 5;
    const int kvsel = item >> 5, g = (item >> 4) & 1, n0 = (item & 15) * 32;
    const bf16* Ab = (const bf16*)(F.ws + WS_KV) + (size_t)kvsel * T * 256 + (size_t)g * T * 128 + (size_t)(n0 + c) * 2048 + wave * 512 + 8 * hf;
    const float* peg = A.in[kvsel ? 6 : 3];
    PLAS float* pel = (PLAS float*)L;
    __syncthreads();
    for (int e = F.tid; e < 1024; e += NTHR) *(PLAS f32x4*)(pel + 4 * e) = *(const f32x4*)(peg + 4 * e);
    __syncthreads();
    const PLAS float* pe = pel + wave * 512 + 8 * hf;
    const bf16* Bb = (const bf16*)(F.ws + WS_W1T) + (size_t)kvsel * 128 * 4096 + (size_t)c * 4096 + wave * 512 + 8 * hf;
    f32x16 acc[4];
#pragma unroll
    for (int cb = 0; cb < 4; ++cb)
#pragma unroll
        for (int r = 0; r < 16; ++r) acc[cb][r] = 0.f;
#pragma unroll 8
    for (int ks = 0; ks < 32; ++ks) {
        const u32x4 aw = *(const u32x4*)(Ab + 16 * ks); const f32x4 p0 = *(const PLAS f32x4*)(pe + 16 * ks), p1 = *(const PLAS f32x4*)(pe + 16 * ks + 4);
        float av[8]; unpack8(aw, av);
        av[0] += p0[0]; av[1] += p0[1]; av[2] += p0[2]; av[3] += p0[3]; av[4] += p1[0]; av[5] += p1[1]; av[6] += p1[2]; av[7] += p1[3];
        const bf16x8 af = pack8(av);
#pragma unroll
        for (int cb = 0; cb < 4; ++cb) { const bf16x8 bfr = *(const bf16x8*)(Bb + (size_t)cb * 32 * 4096 + 16 * ks); acc[cb] = __builtin_amdgcn_mfma_f32_32x32x16_bf16(af, bfr, acc[cb], 0, 0, 0); }
    }
    __syncthreads();
    PLAS float* part = (PLAS float*)L + wave * 32 * CP_STR;
#pragma unroll
    for (int cb = 0; cb < 4; ++cb)
#pragma unroll
        for (int r = 0; r < 16; ++r) part[((r & 3) + 8 * (r >> 2) + 4 * hf) * CP_STR + cb * 32 + c] = acc[cb][r];
    __syncthreads();
    PLAS char* hb = L + CP_HB;
    for (int e = F.tid; e < 32 * 128; e += NTHR) { const int row = e >> 7, col = e & 127; float sum = 0.f;
#pragma unroll
        for (int w = 0; w < 8; ++w) sum += ((PLAS float*)L)[(w * 32 + row) * CP_STR + col];
        *(PLAS unsigned short*)(hb + row * 272 + col * 2) = (unsigned short)f2bf(gelu_t(sum)); }
    __syncthreads();
    if (wave < 4) {
        const bf16* B2 = (const bf16*)(F.ws + WS_W2T) + (size_t)kvsel * 128 * 128 + (size_t)(wave * 32 + c) * 128 + 8 * hf;
        f32x16 o;
#pragma unroll
        for (int r = 0; r < 16; ++r) o[r] = 0.f;
#pragma unroll
        for (int ks = 0; ks < 8; ++ks) { const bf16x8 af = *(const PLAS bf16x8*)(hb + c * 272 + (16 * ks + 8 * hf) * 2); const bf16x8 bfr = *(const bf16x8*)(B2 + 16 * ks);
            o = __builtin_amdgcn_mfma_f32_32x32x16_bf16(af, bfr, o, 0, 0, 0); }
        bf16* dst = (bf16*)(F.ws + WS_KC) + (size_t)kvsel * 2 * 512 * 128 + (size_t)g * 512 * 128;
#pragma unroll
        for (int r = 0; r < 16; ++r) { const int n = n0 + (r & 3) + 8 * (r >> 2) + 4 * hf; dst[(size_t)n * 128 + wave * 32 + c] = (bf16)(n < 511 ? f2bf(o[r]) : 0u); }
    }
    __syncthreads();
}
constexpr int SG_STR = 320;
__device__ __forceinline__ void sgu_item(const Frame& F, const Args& A, int item) {
    PLAS char* L = (PLAS char*)F.lds; const int tid = F.tid, lane = F.lane, wave = F.wave, c = lane & 31, hf = lane >> 5;
    const int ch = item >> 3, g = item & 7;
    const bf16* gu = (const bf16*)(F.ws + WS_U); const bf16* gv = (const bf16*)(F.ws + WS_V); bf16* yb = (bf16*)(F.ws + WS_YB);
    const float* vs = (const float*)(F.ws + WS_VSTAT);
    const float* ln_g = A.in[9]; const float* ln_b = A.in[10]; const float* sw = A.in[11] + (size_t)g * 128 * 128; const float* sb = A.in[12] + g * 128;
    PLAS float* st = (PLAS float*)(L + 128 * SG_STR);
    const int tb = wave >> 1, cb0 = (wave & 1) * 2, t = 32 * tb + c;
    f32x4 sp[8];
    { const f32x4* p = (const f32x4*)(vs + (size_t)(ch * 128 + (tid & 127)) * 32);
#pragma unroll
      for (int i = 0; i < 8; ++i) sp[i] = p[i]; }
    u32x4 vw[4]; f32x4 lg0[4], lg1[4], lb0[4], lb1[4];
#pragma unroll
    for (int i = 0; i < 4; ++i) { const int id = tid + NTHR * i, s = id >> 4, dc = id & 15;
        vw[i] = *(const u32x4*)(gv + (size_t)(ch * 128 + s) * SGW + g * 128 + dc * 8);
        lg0[i] = *(const f32x4*)(ln_g + g * 128 + dc * 8); lg1[i] = *(const f32x4*)(ln_g + g * 128 + dc * 8 + 4); lb0[i] = *(const f32x4*)(ln_b + g * 128 + dc * 8); lb1[i] = *(const f32x4*)(ln_b + g * 128 + dc * 8 + 4); }
    f32x4 wv[8][2];
#pragma unroll
    for (int ks = 0; ks < 8; ++ks) if (ks < 2 * tb + 2) { wv[ks][0] = *(const f32x4*)(sw + (size_t)t * 128 + 16 * ks + 8 * hf); wv[ks][1] = *(const f32x4*)(sw + (size_t)t * 128 + 16 * ks + 8 * hf + 4); }
    unsigned short guv[2][16]; float sbv[16];
#pragma unroll
    for (int r = 0; r < 16; ++r) { const int tt = 32 * tb + (r & 3) + 8 * (r >> 2) + 4 * hf; sbv[r] = sb[tt];
#pragma unroll
        for (int j = 0; j < 2; ++j) guv[j][r] = gu[(size_t)(ch * 128 + tt) * SGW + g * 128 + (cb0 + j) * 32 + c]; }
    if (tid < 128) { float s1 = 0.f, s2 = 0.f;
#pragma unroll
        for (int i = 0; i < 8; ++i) { s1 += sp[i][0] + sp[i][2]; s2 += sp[i][1] + sp[i][3]; }
        const float mean = s1 * (1.0f / SGW), var = fmaxf(s2 * (1.0f / SGW) - mean * mean, 0.f);
        st[2 * tid] = mean; st[2 * tid + 1] = rsqrtf(var + LN_EPS); }
    __syncthreads();
#pragma unroll
    for (int i = 0; i < 4; ++i) { const int id = tid + NTHR * i, s = id >> 4, dc = id & 15;
        float v[8]; unpack8(vw[i], v);
        const float mean = st[2 * s], rstd = st[2 * s + 1];
#pragma unroll
        for (int e = 0; e < 4; ++e) { v[e] = (v[e] - mean) * rstd * lg0[i][e] + lb0[i][e]; v[4 + e] = (v[4 + e] - mean) * rstd * lg1[i][e] + lb1[i][e]; }
        *(PLAS bf16x8*)(L + s * SG_STR + dc * 16) = pack8(v); }
    __syncthreads();
    f32x16 acc[2];
#pragma unroll
    for (int j = 0; j < 2; ++j)
#pragma unroll
        for (int r = 0; r < 16; ++r) acc[j][r] = 0.f;
    const PLAS char* vp = L + (8 * hf + ((lane & 15) >> 2)) * SG_STR + (16 * ((lane >> 4) & 1) + 4 * (lane & 3)) * 2;
#pragma unroll
    for (int ks = 0; ks < 8; ++ks) if (ks < 2 * tb + 2) {
        float av[8]; const int s0 = 16 * ks + 8 * hf;
#pragma unroll
        for (int e = 0; e < 4; ++e) { av[e] = (s0 + e <= t) ? wv[ks][0][e] : 0.f; av[4 + e] = (s0 + 4 + e <= t) ? wv[ks][1][e] : 0.f; }
        const bf16x8 af = pack8(av);
#pragma unroll
        for (int j = 0; j < 2; ++j) { const s16x4 lo = vtr(vp + 16 * ks * SG_STR + (cb0 + j) * 64), hi = vtr(vp + (16 * ks + 4) * SG_STR + (cb0 + j) * 64);
            const bf16x8 bfr = (bf16x8){lo[0], lo[1], lo[2], lo[3], hi[0], hi[1], hi[2], hi[3]};
            acc[j] = __builtin_amdgcn_mfma_f32_32x32x16_bf16(af, bfr, acc[j], 0, 0, 0); }
    }
#pragma unroll
    for (int j = 0; j < 2; ++j)
#pragma unroll
        for (int r = 0; r < 16; ++r) { const int tt = 32 * tb + (r & 3) + 8 * (r >> 2) + 4 * hf;
            yb[(size_t)(ch * 128 + tt) * YLD + g * 128 + (cb0 + j) * 32 + c] = (bf16)f2bf((acc[j][r] + sbv[r]) * bf2f(guv[j][r])); }
    __syncthreads();
}
}
constexpr int SGU_EARLY = 448;
__device__ __forceinline__ void p2_phase(const Frame& F, const Args& A, int b0) {
    const int nb = F.G - b0, b = F.bid - b0;
    if (b < 0) return;
    int it, step, end;
    if (nb >= 128) {
        if (b < 64) { p2::compress_item(F, A, b); it = b; step = 1; end = b + 1; }
        else { it = 64 + (b - 64); step = nb - 64; end = SGU_EARLY; }
    } else {
        for (int c = b; c < 64; c += nb) p2::compress_item(F, A, c);
        it = b; step = nb; end = SGU_EARLY;
    }
    for (; it < end; it += step) p2::sgu_item(F, A, it);
}

namespace nsa {
#define NLAS __attribute__((address_space(3)))
typedef short bf16x8 __attribute__((ext_vector_type(8)));
typedef short s16x4 __attribute__((ext_vector_type(4)));
typedef float f32x16 __attribute__((ext_vector_type(16)));
constexpr int IMPS = 132, KIMG = 16384, STG = 32768;
constexpr int L_IMP = 3 * STG, L_SELM = L_IMP + 64 * IMPS * 4, L_UM = L_SELM + 1024, L_TL = L_UM + 16, L_END = L_TL + 132 * 4;
static_assert(L_END <= LDS_BYTES - 16, "nsa LDS map");
constexpr float NEG = -1.0e30f, M_INIT = -1.0e20f, RESC_THR = 5.0f;

__device__ __forceinline__ void dma_k(const char* kt, int ks, NLAS char* kdst, int wave, int lane) {
    const char* src = kt + (size_t)lane * ks + wave * 32;
    __builtin_amdgcn_global_load_lds((const unsigned*)src, (NLAS unsigned*)(kdst + wave * 2048), 16, 0, 0);
    __builtin_amdgcn_global_load_lds((const unsigned*)(src + 16), (NLAS unsigned*)(kdst + wave * 2048 + 1024), 16, 0, 0);
}
__device__ __forceinline__ void dma_v(const char* vt, int vs, NLAS char* vdst, int wave, int lane) {
    const int db = wave >> 1, pr = 2 * (wave & 1);
    const char* src = vt + (size_t)(16 * pr + (lane >> 2)) * vs + db * 64 + (lane & 3) * 16;
    __builtin_amdgcn_global_load_lds((const unsigned*)src, (NLAS unsigned*)(vdst + db * 4096 + pr * 1024), 16, 0, 0);
    __builtin_amdgcn_global_load_lds((const unsigned*)(src + (size_t)16 * vs), (NLAS unsigned*)(vdst + db * 4096 + pr * 1024 + 1024), 16, 0, 0);
}
#define NSA_WAIT(n) asm volatile("s_waitcnt vmcnt(" #n ") lgkmcnt(0)" ::: "memory")
#define NSA_BAR() do { __builtin_amdgcn_s_barrier(); asm volatile("" ::: "memory"); } while (0)

__device__ __forceinline__ float ror8(float v) { return __uint_as_float((unsigned)__builtin_amdgcn_update_dpp(0, (int)__float_as_uint(v), 0x128  , 0xF, 0xF, false)); }
__device__ __forceinline__ float xor16(float v) {
    auto rr = __builtin_amdgcn_permlane16_swap(__float_as_uint(v), __float_as_uint(v), false, false);
    return (threadIdx.x & 16) ? __uint_as_float(rr[0]) : __uint_as_float(rr[1]);
}
__device__ __forceinline__ float swap_other(float v) {
    auto rr = __builtin_amdgcn_permlane32_swap(__float_as_uint(v), __float_as_uint(v), false, false);
    const unsigned lo = rr[0], hi = rr[1];
    return (threadIdx.x & 32) ? __uint_as_float(lo) : __uint_as_float(hi);
}
#define KCONST(kb, r) (32 * (kb) + ((r) & 3) + 8 * ((r) >> 2))
__device__ __forceinline__ void qk_tile(f32x16 (&S)[2], const NLAS char* kbuf, const bf16x8 (&qf)[8], float base2, float sl2p, int lane) {
    const NLAS char* kp = kbuf + (lane >> 5) * 1024 + (lane & 31) * 16;
#define QK_LD(d0, d1, ks) do { d0 = *(const NLAS bf16x8*)(kp + (ks) * 2048); d1 = *(const NLAS bf16x8*)(kp + (ks) * 2048 + 512); } while (0)
#define QK_MM(s0, s1, ks) do { S[0] = __builtin_amdgcn_mfma_f32_32x32x16_bf16(s0, qf[ks], S[0], 0, 0, 0); S[1] = __builtin_amdgcn_mfma_f32_32x32x16_bf16(s1, qf[ks], S[1], 0, 0, 0); } while (0)
#define SB() __builtin_amdgcn_sched_barrier(0)
    bf16x8 a0, a1, b0, b1;
    QK_LD(a0, a1, 0);
#pragma unroll
    for (int kb = 0; kb < 2; ++kb)
#pragma unroll
        for (int r = 0; r < 16; ++r) S[kb][r] = fmaf(sl2p, (float)KCONST(kb, r), base2);
    SB();
    QK_LD(b0, b1, 1); SB(); QK_MM(a0, a1, 0); SB();
    QK_LD(a0, a1, 2); SB(); QK_MM(b0, b1, 1); SB();
    QK_LD(b0, b1, 3); SB(); QK_MM(a0, a1, 2); SB();
    QK_LD(a0, a1, 4); SB(); QK_MM(b0, b1, 3); SB();
    QK_LD(b0, b1, 5); SB(); QK_MM(a0, a1, 4); SB();
    QK_LD(a0, a1, 6); SB(); QK_MM(b0, b1, 5); SB();
    QK_LD(b0, b1, 7); SB(); QK_MM(a0, a1, 6); SB();
    QK_MM(b0, b1, 7);
#undef QK_LD
#undef QK_MM
}
__device__ __forceinline__ void mask_tile(f32x16 (&S)[2], int dbase, int pscale, unsigned dmax) {
#pragma unroll
    for (int kb = 0; kb < 2; ++kb)
#pragma unroll
        for (int r = 0; r < 16; ++r) { const unsigned d = (unsigned)(dbase - pscale * KCONST(kb, r)); S[kb][r] = d < dmax ? S[kb][r] : NEG; }
}
__device__ __forceinline__ float tile_max(const f32x16 (&S)[2]) {
    float a = fmaxf(S[0][0], S[1][0]);
#pragma unroll
    for (int r = 1; r < 16; ++r) a = fmaxf(fmaxf(a, S[0][r]), S[1][r]);
    return fmaxf(a, swap_other(a));
}
__device__ __forceinline__ s16x4 vtr(const NLAS char* p) { return __builtin_bit_cast(s16x4, __builtin_amdgcn_ds_read_tr16_b64_v4i16((NLAS s16x4*)p)); }
__device__ __forceinline__ void pack_p(bf16x8 (&pf)[4], const f32x16 (&S)[2]) {
#pragma unroll
    for (int kb = 0; kb < 2; ++kb)
#pragma unroll
        for (int s = 0; s < 2; ++s) { u32x4 pw; pw.x = pk2(S[kb][8 * s + 0], S[kb][8 * s + 1]); pw.y = pk2(S[kb][8 * s + 2], S[kb][8 * s + 3]); pw.z = pk2(S[kb][8 * s + 4], S[kb][8 * s + 5]); pw.w = pk2(S[kb][8 * s + 6], S[kb][8 * s + 7]);
            pf[kb * 2 + s] = __builtin_bit_cast(bf16x8, pw); }
}
__device__ __forceinline__ void pv_tile(f32x16 (&O)[4], const bf16x8 (&pf)[4], const NLAS char* vbuf, int lane) {
    const NLAS char* vp = vbuf + (4 * (lane >> 5) + ((lane & 15) >> 2)) * 64 + 32 * ((lane >> 4) & 1) + 8 * (lane & 3);
#define PV_RD(x, off) asm volatile("ds_read_b64_tr_b16 %0, %1 offset:%2" : "=v"(x) : "v"(va), "n"(off))
#define PV_LD(l0, h0, l1, h1, g) do { PV_RD(l0, ((g) >> 1) * 1024 + (2 * ((g) & 1)) * 4096); PV_RD(h0, ((g) >> 1) * 1024 + 512 + (2 * ((g) & 1)) * 4096); \
                                      PV_RD(l1, ((g) >> 1) * 1024 + (2 * ((g) & 1) + 1) * 4096); PV_RD(h1, ((g) >> 1) * 1024 + 512 + (2 * ((g) & 1) + 1) * 4096); } while (0)
#define PV_WT(n, l0, h0, l1, h1) asm volatile("s_waitcnt lgkmcnt(" #n ")" : "+v"(l0), "+v"(h0), "+v"(l1), "+v"(h1))
#define PV_MM(l0, h0, l1, h1, g) do { O[2 * ((g) & 1)] = __builtin_amdgcn_mfma_f32_32x32x16_bf16((bf16x8){l0[0], l0[1], l0[2], l0[3], h0[0], h0[1], h0[2], h0[3]}, pf[(g) >> 1], O[2 * ((g) & 1)], 0, 0, 0); \
                                      O[2 * ((g) & 1) + 1] = __builtin_amdgcn_mfma_f32_32x32x16_bf16((bf16x8){l1[0], l1[1], l1[2], l1[3], h1[0], h1[1], h1[2], h1[3]}, pf[(g) >> 1], O[2 * ((g) & 1) + 1], 0, 0, 0); } while (0)
    const unsigned va = (unsigned)(size_t)vp;
    s16x4 la0, ha0, la1, ha1, lb0, hb0, lb1, hb1;
    PV_LD(la0, ha0, la1, ha1, 0); SB();
    PV_LD(lb0, hb0, lb1, hb1, 1); SB(); PV_WT(4, la0, ha0, la1, ha1); PV_MM(la0, ha0, la1, ha1, 0); SB();
    PV_LD(la0, ha0, la1, ha1, 2); SB(); PV_WT(4, lb0, hb0, lb1, hb1); PV_MM(lb0, hb0, lb1, hb1, 1); SB();
    PV_LD(lb0, hb0, lb1, hb1, 3); SB(); PV_WT(4, la0, ha0, la1, ha1); PV_MM(la0, ha0, la1, ha1, 2); SB();
    PV_LD(la0, ha0, la1, ha1, 4); SB(); PV_WT(4, lb0, hb0, lb1, hb1); PV_MM(lb0, hb0, lb1, hb1, 3); SB();
    PV_LD(lb0, hb0, lb1, hb1, 5); SB(); PV_WT(4, la0, ha0, la1, ha1); PV_MM(la0, ha0, la1, ha1, 4); SB();
    PV_LD(la0, ha0, la1, ha1, 6); SB(); PV_WT(4, lb0, hb0, lb1, hb1); PV_MM(lb0, hb0, lb1, hb1, 5); SB();
    PV_LD(lb0, hb0, lb1, hb1, 7); SB(); PV_WT(4, la0, ha0, la1, ha1); PV_MM(la0, ha0, la1, ha1, 6); SB();
    PV_WT(0, lb0, hb0, lb1, hb1); PV_MM(lb0, hb0, lb1, hb1, 7);
#undef PV_RD
#undef PV_WT
#undef PV_LD
#undef PV_MM
#undef SB
}
__device__ __forceinline__ void pv_sm_tile(f32x16 (&O)[4], bf16x8 (&pf)[4], const NLAS char* vbuf, int lane, f32x16 (&S)[2], float& ls) {
    const NLAS char* vp = vbuf + (4 * (lane >> 5) + ((lane & 15) >> 2)) * 64 + 32 * ((lane >> 4) & 1) + 8 * (lane & 3);
#define SB() __builtin_amdgcn_sched_barrier(0)
#define PV_RD(x, off) asm volatile("ds_read_b64_tr_b16 %0, %1 offset:%2" : "=v"(x) : "v"(va), "n"(off))
#define PV_LD(l0, h0, l1, h1, g) do { PV_RD(l0, ((g) >> 1) * 1024 + (2 * ((g) & 1)) * 4096); PV_RD(h0, ((g) >> 1) * 1024 + 512 + (2 * ((g) & 1)) * 4096); \
                                      PV_RD(l1, ((g) >> 1) * 1024 + (2 * ((g) & 1) + 1) * 4096); PV_RD(h1, ((g) >> 1) * 1024 + 512 + (2 * ((g) & 1) + 1) * 4096); } while (0)
#define PV_WT(n, l0, h0, l1, h1) asm volatile("s_waitcnt lgkmcnt(" #n ")" : "+v"(l0), "+v"(h0), "+v"(l1), "+v"(h1))
#define PV_M0(l0, h0, g) O[2 * ((g) & 1)] = __builtin_amdgcn_mfma_f32_32x32x16_bf16((bf16x8){l0[0], l0[1], l0[2], l0[3], h0[0], h0[1], h0[2], h0[3]}, pf[(g) >> 1], O[2 * ((g) & 1)], 0, 0, 0)
#define PV_M1(l1, h1, g) O[2 * ((g) & 1) + 1] = __builtin_amdgcn_mfma_f32_32x32x16_bf16((bf16x8){l1[0], l1[1], l1[2], l1[3], h1[0], h1[1], h1[2], h1[3]}, pf[(g) >> 1], O[2 * ((g) & 1) + 1], 0, 0, 0)
#define SM_E2(c) do { float s0 = S[(c) >> 3][2 * ((c) & 7)], s1 = S[(c) >> 3][2 * ((c) & 7) + 1]; asm volatile("" : "+v"(s0), "+v"(s1)); \
                      float p0 = __builtin_amdgcn_exp2f(s0), p1 = __builtin_amdgcn_exp2f(s1); ls += p0; ls += p1; asm volatile("" : "+v"(p0), "+v"(p1), "+v"(ls)); \
                      S[(c) >> 3][2 * ((c) & 7)] = p0; S[(c) >> 3][2 * ((c) & 7) + 1] = p1; } while (0)
#define SM_PKH(k, h) do { u32x2 pw; pw.x = pk2(S[(k) >> 1][8 * ((k) & 1) + 4 * (h) + 0], S[(k) >> 1][8 * ((k) & 1) + 4 * (h) + 1]); pw.y = pk2(S[(k) >> 1][8 * ((k) & 1) + 4 * (h) + 2], S[(k) >> 1][8 * ((k) & 1) + 4 * (h) + 3]); \
                            asm volatile("" : "+v"(pw.x), "+v"(pw.y)); u32x4 w_ = __builtin_bit_cast(u32x4, pf[k]); w_[2 * (h)] = pw.x; w_[2 * (h) + 1] = pw.y; pf[k] = __builtin_bit_cast(bf16x8, w_); } while (0)
    const unsigned va = (unsigned)(size_t)vp;
    s16x4 la0, ha0, la1, ha1, lb0, hb0, lb1, hb1;
    PV_LD(la0, ha0, la1, ha1, 0); SB();
    PV_LD(lb0, hb0, lb1, hb1, 1); SB(); PV_WT(4, la0, ha0, la1, ha1); PV_M0(la0, ha0, 0); SB(); SM_E2(0); SB(); PV_M1(la1, ha1, 0); SB(); SM_E2(1); SB();
    PV_LD(la0, ha0, la1, ha1, 2); SB(); PV_WT(4, lb0, hb0, lb1, hb1); PV_M0(lb0, hb0, 1); SB(); SM_E2(2); SB(); PV_M1(lb1, hb1, 1); SB(); SM_E2(3); SB();
    PV_LD(lb0, hb0, lb1, hb1, 3); SB(); PV_WT(4, la0, ha0, la1, ha1); PV_M0(la0, ha0, 2); SB(); SM_E2(4); SM_PKH(0, 0); SB(); PV_M1(la1, ha1, 2); SB(); SM_E2(5); SM_PKH(0, 1); SB();
    PV_LD(la0, ha0, la1, ha1, 4); SB(); PV_WT(4, lb0, hb0, lb1, hb1); PV_M0(lb0, hb0, 3); SB(); SM_E2(6); SB(); PV_M1(lb1, hb1, 3); SB(); SM_E2(7); SB();
    PV_LD(lb0, hb0, lb1, hb1, 5); SB(); PV_WT(4, la0, ha0, la1, ha1); PV_M0(la0, ha0, 4); SB(); SM_E2(8); SM_PKH(1, 0); SB(); PV_M1(la1, ha1, 4); SB(); SM_E2(9); SM_PKH(1, 1); SB();
    PV_LD(la0, ha0, la1, ha1, 6); SB(); PV_WT(4, lb0, hb0, lb1, hb1); PV_M0(lb0, hb0, 5); SB(); SM_E2(10); SB(); PV_M1(lb1, hb1, 5); SB(); SM_E2(11); SB();
    PV_LD(lb0, hb0, lb1, hb1, 7); SB(); PV_WT(4, la0, ha0, la1, ha1); PV_M0(la0, ha0, 6); SB(); SM_E2(12); SM_PKH(2, 0); SB(); PV_M1(la1, ha1, 6); SB(); SM_E2(13); SM_PKH(2, 1); SB();
    PV_WT(0, lb0, hb0, lb1, hb1); PV_M0(lb0, hb0, 7); SB(); SM_E2(14); SB(); PV_M1(lb1, hb1, 7); SB(); SM_E2(15); SB();
    SM_PKH(3, 0); SM_PKH(3, 1);
#undef PV_RD
#undef PV_LD
#undef PV_WT
#undef PV_M0
#undef PV_M1
#undef SM_E2
#undef SM_PKH
#undef SB
}
__device__ __forceinline__ void y_store(float* yp, const f32x16 (&O)[4], float f) {
#pragma unroll
    for (int db = 0; db < 4; ++db)
#pragma unroll
        for (int i = 0; i < 4; ++i) { f32x4 v; v[0] = O[db][4 * i] * f; v[1] = O[db][4 * i + 1] * f; v[2] = O[db][4 * i + 2] * f; v[3] = O[db][4 * i + 3] * f; *(f32x4*)(yp + 32 * db + 8 * i) = v; }
}

#define NSA_WAITN(n) do { const int _n = (n); if (_n >= 4) NSA_WAIT(4); else if (_n >= 2) NSA_WAIT(2); else NSA_WAIT(0); } while (0)
template <bool WIN> __device__ __forceinline__ void online_branch(const Frame& F, int tid, NLAS char* L, const bf16x8 (&qf)[8], f32x16 (&O)[4], float& l_out,
        const char* kg, const char* vg, const NLAS int* tl, int nt, int t, float sl2, int cur, const NLAS unsigned* selq) {
    const int lane = tid & 63, hf = lane >> 5, wave = F.wave;
    float m = 0.f, l = 0.f;
#pragma unroll
    for (int db = 0; db < 4; ++db)
#pragma unroll
        for (int r = 0; r < 16; ++r) O[db][r] = 0.f;
#define NSA_BEHIND(i) (2 * (((i) + 1 < nt ? 1 : 0) + ((i) < nt ? 1 : 0)))
    { const int j0 = tl[0]; dma_k(kg + (size_t)j0 * 64 * 512, 512, L, wave, lane);
      if (nt > 1) { const int j1 = tl[1]; dma_k(kg + (size_t)j1 * 64 * 512, 512, L + STG, wave, lane); }
      dma_v(vg + (size_t)j0 * 64 * 512, 512, L + KIMG, wave, lane); }
    int s_i = 0, s_im1 = 2 * STG;
    bf16x8 pf[4]; f32x16 S[2];
#define NSA_SCORES(i, alpha) do { \
        const int j = tl[i]; \
        bool colsel = true; \
        if (!WIN) { const unsigned w = selq[j >> 5]; colsel = (w >> (j & 31)) & 1u; } \
        const int dbase = t - 64 * j - 4 * hf; \
        const float base2 = colsel ? -sl2 * (float)dbase - m : NEG;     \
        qk_tile(S, L + s_i, qf, base2, sl2, lane); \
        const bool need_mask = WIN ? (j == cur || j == cur - 8) : (j == cur); \
        if (__builtin_amdgcn_readfirstlane((int)need_mask)) { asm volatile("" : "+v"(S[0]), "+v"(S[1])); mask_tile(S, dbase, 1, WIN ? 512u : 0x7fffffffu); }     \
        const float mx = tile_max(S); \
          \
        if ((i) == 0 || __any(mx > RESC_THR)) { const float dl = (i) == 0 ? (mx > -1.0e29f ? mx : 0.f) : fmaxf(mx, 0.f);     \
            alpha = (i) == 0 ? 1.0f : __builtin_amdgcn_exp2f(-dl); l *= alpha; m += dl; \
            _Pragma("unroll") for (int kb2 = 0; kb2 < 2; ++kb2) _Pragma("unroll") for (int r = 0; r < 16; ++r) S[kb2][r] -= dl; } \
    } while (0)
#define NSA_TOP(i) do { NSA_WAITN(NSA_BEHIND(i)); NSA_BAR(); \
        if ((i) + 2 < nt) { const int j2 = tl[(i) + 2]; dma_k(kg + (size_t)j2 * 64 * 512, 512, L + s_im1, wave, lane); }            \
        if ((i) + 1 < nt) { const int j1 = tl[(i) + 1]; dma_v(vg + (size_t)j1 * 64 * 512, 512, L + (s_i == 2 * STG ? 0 : s_i + STG) + KIMG, wave, lane); } } while (0)
#define NSA_ADV() do { const int s_n = s_i == 2 * STG ? 0 : s_i + STG; s_im1 = s_i; s_i = s_n; } while (0)
    {
        NSA_TOP(0);
        float alpha = 1.0f; NSA_SCORES(0, alpha);
        float ls = 0.f;
#pragma unroll
        for (int kb2 = 0; kb2 < 2; ++kb2)
#pragma unroll
            for (int r = 0; r < 16; ++r) { const float p = __builtin_amdgcn_exp2f(S[kb2][r]); S[kb2][r] = p; ls += p; }
        pack_p(pf, S); l += ls;
        NSA_ADV();
    }
    for (int i = 1; i < nt; ++i) {
        NSA_TOP(i);
        float alpha = 1.0f; NSA_SCORES(i, alpha);
        float ls = 0.f;
        pv_sm_tile(O, pf, L + s_im1 + KIMG, lane, S, ls);
        l += ls;
        if (__any(alpha != 1.0f)) {
#pragma unroll
            for (int db = 0; db < 4; ++db)
#pragma unroll
                for (int r = 0; r < 16; ++r) O[db][r] *= alpha; }
        NSA_ADV();
    }
    { NSA_TOP(nt); pv_tile(O, pf, L + s_im1 + KIMG, lane); }
#undef NSA_SCORES
#undef NSA_TOP
#undef NSA_ADV
    NSA_WAIT(0); NSA_BAR();
#undef NSA_BEHIND
    l_out = l + swap_other(l);
}
}

__device__ __forceinline__ void p3_attn(const Frame& F, const Args& A) {
    using namespace nsa;
    NLAS char* L = (NLAS char*)F.lds;
    const int wave = F.wave;
    const bf16* qb = (const bf16*)(F.ws + WS_Q); const char* kvb = (const char*)(F.ws + WS_KV);
    const char* kcb = (const char*)(F.ws + WS_KC); const float* ng = (const float*)(F.ws + WS_NSAG); bf16* ya = (bf16*)(F.ws + WS_YA);
    float* y32a = A.out; float* y32b = (float*)(F.ws + WS_WIN);
    NLAS float* imp = (NLAS float*)(L + L_IMP); NLAS unsigned* selm = (NLAS unsigned*)(L + L_SELM); NLAS unsigned* um = (NLAS unsigned*)(L + L_UM); NLAS int* tl = (NLAS int*)(L + L_TL);
    const int vcu = (F.G % 8 == 0) ? (F.bid % 8) * (F.G / 8) + F.bid / 8 : F.bid;
    for (int item = vcu; item < 256; item += F.G) {
        int tid = F.tid; asm volatile("" : "+v"(tid));
        const int lane = tid & 63, c = lane & 31, hf = lane >> 5, qi = c & 7, hh = c >> 3;
        const int tq = 127 - (item >> 1), g = item & 1, t0 = 64 * tq, cur = tq;
        const int t = t0 + 8 * wave + qi, head = 4 * g + hh;
        const float sl2 = exp2f(-(float)(head + 1)) * LOG2E;
        bf16x8 qf[8];
#pragma unroll
        for (int ks = 0; ks < 8; ++ks) qf[ks] = *(const bf16x8*)(qb + (size_t)t * QW + head * 128 + 16 * ks + 8 * hf);
        const float* gp = ng + (size_t)t * 24 + head * 3;
        const size_t ycol = (size_t)t * QW + head * 128 + 4 * hf;
        asm volatile("s_waitcnt vmcnt(0)" ::: "memory");
        __syncthreads();
        for (int e = tid; e < 64 * IMPS; e += NTHR) imp[e] = 0.f;
        if (tid < 4) um[tid] = 0u;
        const int nvmax = ((t0 + 63 - 31) >> 4) + 1, ntc = (nvmax + 63) >> 6;
        const char* kc = kcb + (size_t)g * 512 * 256; const char* vc = kcb + (size_t)2 * 512 * 256 + (size_t)g * 512 * 256;
        float m = M_INIT, l = 0.f;
        for (int rp = 0; rp < (ATT_DBL == 1 ? 2 : 1); ++rp) {
        m = M_INIT; l = 0.f;
        dma_k(kc, 256, L, wave, lane); if (ntc > 1) dma_k(kc + (size_t)64 * 256, 256, L + STG, wave, lane);
        int s_cur = 0, s_nxt2 = 2 * STG;
        for (int i = 0; i < ntc; ++i) {
            if (i + 1 < ntc) NSA_WAIT(2); else NSA_WAIT(0);
            NSA_BAR();
            if (i + 2 < ntc) dma_k(kc + (size_t)(i + 2) * 64 * 256, 256, L + s_nxt2, wave, lane);
            const int nb = 64 * i; const int dbase = t - 31 - 16 * (nb + 4 * hf);
            f32x16 S[2];
            qk_tile(S, L + s_cur, qf, -sl2 * (float)dbase, sl2 * 16.f, lane);
            if (16 * (nb + 63) + 31 > t0) { asm volatile("" : "+v"(S[0]), "+v"(S[1])); mask_tile(S, dbase, 16, 0x7fffffffu); }
            const float mnew = fmaxf(m, tile_max(S));
            l *= __builtin_amdgcn_exp2f(m - mnew); m = mnew;
            float ls = 0.f;
#pragma unroll
            for (int kb2 = 0; kb2 < 2; ++kb2)
#pragma unroll
                for (int r = 0; r < 16; ++r) ls += __builtin_amdgcn_exp2f(S[kb2][r] - m);
            l += ls;
            s_nxt2 = s_cur; s_cur = (s_cur == 2 * STG) ? 0 : s_cur + STG;
        }
        NSA_WAIT(0); NSA_BAR();
        }
        l += swap_other(l);
        const float inv_l = l > 0.f ? 1.0f / l : 0.f;
        f32x16 O[4];
        for (int rp = 0; rp < (ATT_DBL == 2 ? 2 : 1); ++rp) {
        const bool do_imp = (rp == (ATT_DBL == 2 ? 1 : 0));
#pragma unroll
        for (int db = 0; db < 4; ++db)
#pragma unroll
            for (int r = 0; r < 16; ++r) O[db][r] = 0.f;
        dma_k(kc, 256, L, wave, lane); dma_v(vc, 256, L + KIMG, wave, lane);
        if (ntc > 1) { dma_k(kc + (size_t)64 * 256, 256, L + STG, wave, lane); dma_v(vc + (size_t)64 * 256, 256, L + STG + KIMG, wave, lane); }
        int s_cur = 0, s_nxt2 = 2 * STG;
        for (int i = 0; i < ntc; ++i) {
            if (i + 1 < ntc) NSA_WAIT(4); else NSA_WAIT(0);
            NSA_BAR();
            if (i + 2 < ntc) { dma_k(kc + (size_t)(i + 2) * 64 * 256, 256, L + s_nxt2, wave, lane); dma_v(vc + (size_t)(i + 2) * 64 * 256, 256, L + s_nxt2 + KIMG, wave, lane); }
            const int nb = 64 * i; const int dbase = t - 31 - 16 * (nb + 4 * hf);
            f32x16 S[2];
            qk_tile(S, L + s_cur, qf, -sl2 * (float)dbase - m, sl2 * 16.f, lane);
            if (16 * (nb + 63) + 31 > t0) { asm volatile("" : "+v"(S[0]), "+v"(S[1])); mask_tile(S, dbase, 16, 0x7fffffffu); }
#pragma unroll
            for (int kb2 = 0; kb2 < 2; ++kb2)
#pragma unroll
                for (int r = 0; r < 16; ++r) S[kb2][r] = __builtin_amdgcn_exp2f(S[kb2][r]) * inv_l;
#pragma unroll
            for (int kb2 = 0; kb2 < 2; ++kb2)
#pragma unroll
                for (int i2 = 0; i2 < 4; ++i2) {
                    const float p3 = S[kb2][4 * i2 + 3];
                    float cm = 32.f * ((S[kb2][4 * i2] + S[kb2][4 * i2 + 1]) + S[kb2][4 * i2 + 2]) + 16.f * p3, cn = 16.f * p3;
                    cm += ror8(cm); cm += xor16(cm); cn += ror8(cn); cn += xor16(cn);
                    if (hh == 0 && do_imp) { const int j = ((nb + 32 * kb2) >> 2) + 2 * i2 + hf; NLAS float* ip = imp + (8 * wave + qi) * IMPS + j; ip[0] += cm; }
                    asm volatile("" ::: "memory");
                    if (hh == 0 && do_imp) { const int j = ((nb + 32 * kb2) >> 2) + 2 * i2 + hf; NLAS float* ip = imp + (8 * wave + qi) * IMPS + j; ip[1] += cn; }
                    asm volatile("" ::: "memory");
                }
            { bf16x8 pf[4]; pack_p(pf, S); pv_tile(O, pf, L + s_cur + KIMG, lane); }
            s_nxt2 = s_cur; s_cur = (s_cur == 2 * STG) ? 0 : s_cur + STG;
        }
        NSA_WAIT(0); NSA_BAR();
        }
        y_store(y32a + ycol, O, gp[0]);
        for (int rp = 0; rp < (ATT_DBL == 3 ? 2 : 1); ++rp) {
            unsigned m0 = 0u, m1 = 0u, m2 = 0u, m3 = 0u; const int q = tid >> 3, part = tid & 7;
            unsigned k[16];
#pragma unroll
            for (int i4 = 0; i4 < 4; ++i4) { const f32x4 raw = *(const NLAS f32x4*)(imp + q * IMPS + part * 16 + 4 * i4);
#pragma unroll
                for (int e = 0; e < 4; ++e) { const int j = part * 16 + 4 * i4 + e; const bool forced = (j == 0) || (j == cur) || (j == cur - 1);
                    const unsigned vb = forced ? 0x49742400u   : __float_as_uint(raw[e]);
                    k[4 * i4 + e] = (j <= cur || forced) ? ((vb & 0xFFFFFF00u) | (unsigned)(255 - j)) : 0u; } }
            unsigned prev = 0xFFFFFFFFu;
            for (int r = 0; r < 16; ++r) {
                unsigned bk = 0u;
#pragma unroll
                for (int i = 0; i < 16; ++i) { const unsigned c = k[i] < prev ? k[i] : 0u; bk = c > bk ? c : bk; }
                { const unsigned o = (unsigned)__builtin_amdgcn_update_dpp(0, (int)bk, 0xB1, 0xF, 0xF, false); bk = o > bk ? o : bk; }
                { const unsigned o = (unsigned)__builtin_amdgcn_update_dpp(0, (int)bk, 0x4E, 0xF, 0xF, false); bk = o > bk ? o : bk; }
                { const unsigned o = (unsigned)__builtin_amdgcn_update_dpp(0, (int)bk, 0x141, 0xF, 0xF, false); bk = o > bk ? o : bk; }
                prev = bk;
                if (bk != 0u) { const int bi = 255 - (int)(bk & 0xFFu); const unsigned bit = 1u << (bi & 31); const int w = bi >> 5; m0 |= w == 0 ? bit : 0u; m1 |= w == 1 ? bit : 0u; m2 |= w == 2 ? bit : 0u; m3 |= w == 3 ? bit : 0u; }
            }
            if (part == 0) { selm[q * 4 + 0] = m0; selm[q * 4 + 1] = m1; selm[q * 4 + 2] = m2; selm[q * 4 + 3] = m3;
                atomicOr((unsigned*)(um + 0), m0); atomicOr((unsigned*)(um + 1), m1); atomicOr((unsigned*)(um + 2), m2); atomicOr((unsigned*)(um + 3), m3); }
        }
        __syncthreads();
        int nts;
        {
            const unsigned u0 = um[0], u1 = um[1], u2 = um[2], u3 = um[3];
            nts = __popc(u0) + __popc(u1) + __popc(u2) + __popc(u3);
            if (tid < 128) { const int w = tid >> 5, b = tid & 31; const unsigned uw = w == 0 ? u0 : w == 1 ? u1 : w == 2 ? u2 : u3;
                if ((uw >> b) & 1u) { int rank = __popc((uw >> b) >> 1); if (w < 3) rank += __popc(u3); if (w < 2) rank += __popc(u2); if (w < 1) rank += __popc(u1); tl[rank] = tid; } }
        }
        asm volatile("s_waitcnt vmcnt(0)" ::: "memory");
        __syncthreads();
        float lb;
        for (int rp = 0; rp < (ATT_DBL == 4 ? 2 : 1); ++rp)
        online_branch<false>(F, tid, L, qf, O, lb, kvb + (size_t)2 * T * 512 + g * 256, kvb + (size_t)3 * T * 512 + g * 256, tl, nts, t, sl2, cur, selm + (8 * wave + qi) * 4);
        y_store(y32b + ycol, O, lb > 0.f ? gp[1] / lb : 0.f);
        const int ntw = cur >= 8 ? 9 : cur + 1;
        if (tid < ntw) tl[tid] = cur - tid;
        asm volatile("s_waitcnt vmcnt(0)" ::: "memory");
        __syncthreads();
        for (int rp = 0; rp < (ATT_DBL == 5 ? 2 : 1); ++rp)
        online_branch<true>(F, tid, L, qf, O, lb, kvb + (size_t)4 * T * 512 + g * 256, kvb + (size_t)5 * T * 512 + g * 256, tl, ntw, t, sl2, cur, selm);
        { const float f = lb > 0.f ? gp[2] / lb : 0.f; const float* pa = y32a + ycol; const float* pb = y32b + ycol; bf16* po = ya + (size_t)t * YLD + head * 128 + 4 * hf;
#pragma unroll
          for (int db = 0; db < 4; ++db)
#pragma unroll
            for (int i = 0; i < 4; ++i) { const f32x4 a = *(const f32x4*)(pa + 32 * db + 8 * i), b = *(const f32x4*)(pb + 32 * db + 8 * i);
                u32x2 w; w.x = pk2(a[0] + b[0] + O[db][4 * i] * f, a[1] + b[1] + O[db][4 * i + 1] * f); w.y = pk2(a[2] + b[2] + O[db][4 * i + 2] * f, a[3] + b[3] + O[db][4 * i + 3] * f);
                *(u32x2*)(po + 32 * db + 8 * i) = w; } }
    }
    __syncthreads();
}

#define XB_ROWCNT(pm) (3584 + 16 * (pm))
struct EpiResNorm {
    static constexpr bool PERM = false, AFTER_DRAIN = false, HAS_MID = false, USES_LDS = false;
    const bf16* xb; float* part; unsigned* bar; const float* fg; float* out;
    __device__ __forceinline__ void operator()(f32x4 (&acc)[2][2][4][2], const Unit& u, int wr, int wc, int fr, int fq) const {
        const int row0 = u.pm * 256 + wr * 64 + fr, col0 = u.pn * 256 + wc * 32 + 4 * fq;
#pragma unroll
        for (int ai = 0; ai < 2; ++ai)
#pragma unroll
            for (int m = 0; m < 4; ++m) { const int row = row0 + ai * 128 + m * 16; const size_t ro = (size_t)row * 2048 + col0; float ss = 0.f;
#pragma unroll
                for (int bj = 0; bj < 2; ++bj)
#pragma unroll
                    for (int n = 0; n < 2; ++n) { const size_t o = ro + bj * 128 + n * 16; const u32x2 xw = *(const u32x2*)(xb + o);
                        f32x4 v = acc[ai][bj][m][n]; v[0] += bflo(xw.x); v[1] += bfhi(xw.x); v[2] += bflo(xw.y); v[3] += bfhi(xw.y);
                        ss += (v[0] * v[0] + v[1] * v[1]) + (v[2] * v[2] + v[3] * v[3]); acc[ai][bj][m][n] = v; }
                ss += __shfl_xor(ss, 16); ss += __shfl_xor(ss, 32);
                if (fq == 0) __hip_atomic_store(part + (size_t)row * 32 + u.pn * 4 + wc, ss, __ATOMIC_RELAXED, __HIP_MEMORY_SCOPE_AGENT); }
        asm volatile("s_waitcnt vmcnt(0)" ::: "memory");
        __syncthreads();
        if (threadIdx.x == 0) { unsigned* c = bar + XB_ROWCNT(u.pm); (void)xb_add(c, 1u); XB_SPIN(xb_ld(c) < 8u, bar); }
        __syncthreads();
        float rs[2][4];
#pragma unroll
        for (int ai = 0; ai < 2; ++ai)
#pragma unroll
            for (int m = 0; m < 4; ++m) { const int row = row0 + ai * 128 + m * 16; const unsigned long long* pp = (const unsigned long long*)(part + (size_t)row * 32 + fq * 8); float ss = 0.f;
#pragma unroll
                for (int i = 0; i < 4; ++i) { const unsigned long long w = __hip_atomic_load(pp + i, __ATOMIC_RELAXED, __HIP_MEMORY_SCOPE_AGENT); ss += __uint_as_float((unsigned)w) + __uint_as_float((unsigned)(w >> 32)); }
                rs[ai][m] = ss; }
#pragma unroll
        for (int ai = 0; ai < 2; ++ai)
#pragma unroll
            for (int m = 0; m < 4; ++m) { float ss = rs[ai][m]; ss += __shfl_xor(ss, 16); ss += __shfl_xor(ss, 32); rs[ai][m] = rsqrtf(ss * (1.0f / DM) + NORM_EPS); }
#pragma unroll
        for (int bj = 0; bj < 2; ++bj)
#pragma unroll
            for (int n = 0; n < 2; ++n) { const f32x4 g4 = *(const f32x4*)(fg + col0 + bj * 128 + n * 16);
#pragma unroll
                for (int ai = 0; ai < 2; ++ai)
#pragma unroll
                    for (int m = 0; m < 4; ++m) { const int row = row0 + ai * 128 + m * 16; const float r = rs[ai][m]; const f32x4 v = acc[ai][bj][m][n];
                        f32x4 o; o[0] = v[0] * r * g4[0]; o[1] = v[1] * r * g4[1]; o[2] = v[2] * r * g4[2]; o[3] = v[3] * r * g4[3];
                        *(f32x4*)(out + (size_t)row * 2048 + col0 + bj * 128 + n * 16) = o; } }
    }
};

__device__ __forceinline__ void p8_final(const Frame& F, const Args& A) {
    const int gw = F.bid * NWAVES + F.wave, NGW = F.G * NWAVES;
    const float* part = (const float*)(F.ws + WS_P3); const float* fg = A.in[21]; const bf16* x3 = (const bf16*)(F.ws + WS_H);
    f32x4 gq[8];
#pragma unroll
    for (int j = 0; j < 4; ++j) { gq[2 * j] = ((const f32x4*)fg)[(F.lane + 64 * j) * 2]; gq[2 * j + 1] = ((const f32x4*)fg)[(F.lane + 64 * j) * 2 + 1]; }
    for (int m0 = gw; m0 < T; m0 += 2 * NGW) {
        const int m1 = m0 + NGW; const bool has1 = m1 < T; const int m1c = has1 ? m1 : m0;
        const float s0 = F.lane < 32 ? part[(size_t)m0 * 32 + F.lane] : 0.f, s1 = F.lane < 32 ? part[(size_t)m1c * 32 + F.lane] : 0.f;
        u32x4 w0[4], w1[4];
#pragma unroll
        for (int j = 0; j < 4; ++j) { w0[j] = ((const u32x4*)(x3 + (size_t)m0 * DM))[F.lane + 64 * j]; w1[j] = ((const u32x4*)(x3 + (size_t)m1c * DM))[F.lane + 64 * j]; }
        const float r0 = rsqrtf(wave_sum(s0) * (1.0f / DM) + NORM_EPS), r1 = rsqrtf(wave_sum(s1) * (1.0f / DM) + NORM_EPS);
#pragma unroll
        for (int rr = 0; rr < 2; ++rr) { if (rr == 1 && !has1) break; const float r = rr ? r1 : r0; f32x4* orow = (f32x4*)(A.out + (size_t)(rr ? m1 : m0) * DM);
#pragma unroll
            for (int j = 0; j < 4; ++j) { const u32x4 w = rr ? w1[j] : w0[j]; const int c4 = (F.lane + 64 * j) * 2; const f32x4 g0 = gq[2 * j], g1 = gq[2 * j + 1];
                f32x4 o0, o1; o0[0] = bflo(w.x) * r * g0[0]; o0[1] = bfhi(w.x) * r * g0[1]; o0[2] = bflo(w.y) * r * g0[2]; o0[3] = bfhi(w.y) * r * g0[3];
                o1[0] = bflo(w.z) * r * g1[0]; o1[1] = bfhi(w.z) * r * g1[1]; o1[2] = bflo(w.w) * r * g1[2]; o1[3] = bfhi(w.w) * r * g1[3];
                orow[c4] = o0; orow[c4 + 1] = o1; } }
    }
}

constexpr int NPHASE = 10;
__global__ void __launch_bounds__(NTHR, 2) mega_fwd(Args args) {
    extern __shared__ __attribute__((aligned(16))) unsigned char lds[];
    cg::grid_group grid = cg::this_grid();
    Frame F; F.lds = lds; F.tid = threadIdx.x; F.lane = F.tid & 63; F.wave = __builtin_amdgcn_readfirstlane(F.tid >> 6); F.G = gridDim.x; F.bid = blockIdx.x; F.ws = args.ws;
    PG8_LAS unsigned char* lds3 = (PG8_LAS unsigned char*)lds;
    const int lo = args.ph_lo, hi = args.ph_hi;
    volatile __attribute__((address_space(3))) unsigned* xst = (volatile __attribute__((address_space(3))) unsigned*)(lds3 + LDS_BYTES - 16);
    if (F.tid == 0) { xst[0] = 0u; xst[1] = 0u; }
    __syncthreads();
    if (MK_ONE_LAUNCH && GSYNC_SEAM == 0 && F.bid == 0) { unsigned* bw = (unsigned*)(args.ws + WS_BAR); for (int e = F.tid; e < 4096; e += NTHR) bw[e] = 0u; }
    XcdBarrier xbar; xbar.bar = (unsigned*)(args.ws + WS_BAR); xbar.x = 0; xbar.st = xst;
    if (MK_ONE_LAUNCH && GSYNC_SEAM != 0) xbar = xcd_barrier_post((unsigned*)(args.ws + WS_BAR), xst);
#define IN(k) (lo <= (k) && (k) < hi)
#define SEAM(k) do { if (IN(k) && IN((k) + 1)) { if ((k) == GSYNC_SEAM) grid.sync(); else xcd_barrier(xbar); } } while (0)
    unsigned char* ws = args.ws;
#define PH0 { p0_prologue(F, args); if (!FILL_FFN_IN_P1) convert_wffn(F, args, F.bid, F.G); if (!FILL_DOWN_IN_P6) convert_wdown(F, args, F.bid, F.G); }
#define PH1 { pg8::Gemm g{(const bf16*)(ws + WS_H), (const bf16*)(ws + WS_WIN), T, NP0M, DM, DM}; pg8::StaticOrder S; S.init(T, NP0M, F.G, F.bid); S.wgm = WGM_BIG; \
        Epi0 E{ws, 0}; pg8::gemm_phase<Epi0, pg8::StaticOrder, true, true>(lds3, g, S, E); }
#define PH2 { const int gt = F.G >= 256 ? 96 : F.G; \
        if (F.bid < gt) { pg8::Gemm g{(const bf16*)(ws + WS_H), (const bf16*)(ws + WS_WIN) + (size_t)NP0M * DM, T, NP0 - NP0M, DM, DM}; pg8::StaticOrder S; S.init(T, NP0 - NP0M, gt, F.bid); \
            Epi0 E{ws, NP0M / 256}; pg8::gemm_phase<Epi0, pg8::StaticOrder, true, true>(lds3, g, S, E); } \
        __syncthreads(); p2_phase(F, args, F.G >= 256 ? 96 : 0); }
#define PH3 { p3_attn(F, args); \
        const int vcu3 = (F.G % 8 == 0) ? (F.bid % 8) * (F.G / 8) + F.bid / 8 : F.bid;     \
        int it = F.G >= 256 ? SGU_EARLY + (vcu3 - 192) : SGU_EARLY + F.bid; const int step = F.G >= 256 ? 512 : F.G; \
        if (it >= SGU_EARLY) for (; it < 512; it += step) p2::sgu_item(F, args, it); }
#define PH4 { pg8::Gemm g{(const bf16*)(ws + WS_YA), (const bf16*)(ws + WS_WPA), T, DM, 1024, DM}; pg8::MixOrder S; S.init(T, DM, F.G, F.bid); S.wgm = WGM_MIX; \
        EpiMix E{(const bf16*)(ws + WS_GA), (const bf16*)(ws + WS_GB), (bf16*)(ws + WS_MIXED)}; pg8::gemm_phase<EpiMix, pg8::MixOrder, true, true>(lds3, g, S, E); }
#define PH5 { pg8::Gemm g{(const bf16*)(ws + WS_MIXED), (const bf16*)(ws + WS_WOUT), T, DM, DM, DM}; pg8::StaticOrder S; S.init(T, DM, F.G, F.bid); S.wgm = WGM_MIX; \
        EpiRes E{args.in[0], nullptr, (bf16*)(ws + WS_H), (float*)(ws + WS_P2)}; pg8::gemm_phase<EpiRes, pg8::StaticOrder, true, true>(lds3, g, S, E); }
#define PH6 { pg8::Gemm g{(const bf16*)(ws + WS_H), (const bf16*)(ws + WS_WFFN), T, 2 * DFF, DM, DM}; pg8::FfnOrder S; S.init_tiles(34, 43, F.G, F.bid); S.wgm = WGM_BIG; \
        EpiFfnConv E{(const float*)(ws + WS_P2), args.in[18], args.in[19], (bf16*)(ws + WS_G)}; pg8::gemm_phase<EpiFfnConv, pg8::FfnOrder, true, true>(lds3, g, S, E); \
        if (FILL_DOWN_IN_P6) { const int rem = S.nwg % F.G; if (rem != 0 && F.bid >= rem) convert_wdown(F, args, F.bid - rem, F.G - rem); else if (rem == 0) convert_wdown(F, args, F.bid, F.G); } }
#define PH7 { pg8::Gemm g{(const bf16*)(ws + WS_G), (const bf16*)(ws + WS_WDOWN), T, DM, DFF, 64, (size_t)T * 128, (size_t)DM * 128};     pg8::StaticOrder S; S.init(T, DM, F.G, F.bid); \
        if (FUSE78) { EpiResNorm E{(const bf16*)(ws + WS_H), (float*)(ws + WS_P3), (unsigned*)(ws + WS_BAR), args.in[21], args.out}; pg8::gemm_phase<EpiResNorm, pg8::StaticOrder, true, true>(lds3, g, S, E); } \
        else { EpiResB E{(bf16*)(ws + WS_H), (float*)(ws + WS_P3)}; pg8::gemm_phase<EpiResB, pg8::StaticOrder, true, true>(lds3, g, S, E); } }
#define PH8 { p8_final(F, args); }
    if (IN(0)) PH0
#if DBL_PHASE == 0
    grid.sync(); PH0
#endif
    SEAM(0);
    if (MK_ONE_LAUNCH && GSYNC_SEAM == 0) xbar = xcd_barrier_post((unsigned*)(args.ws + WS_BAR), xst);
    if (IN(1)) PH1
#if DBL_PHASE == 1
    grid.sync(); PH1
#endif
    SEAM(1);
    if (IN(2)) PH2
#if DBL_PHASE == 2
    grid.sync(); PH2
#endif
    SEAM(2);
    if (IN(3)) PH3
#if DBL_PHASE == 3
    grid.sync(); PH3
#endif
    SEAM(3);
    if (IN(4)) PH4
#if DBL_PHASE == 4
    grid.sync(); PH4
#endif
    SEAM(4);
    if (IN(5)) PH5
#if DBL_PHASE == 5
    grid.sync(); PH5
#endif
    SEAM(5);
    if (IN(6)) PH6
#if DBL_PHASE == 6
    grid.sync(); PH6
#endif
    SEAM(6);
    const bool FUSE78 = MK_ONE_LAUNCH && F.G >= 256;
    if (IN(7)) PH7
    if (!FUSE78) { SEAM(7);
    if (IN(8)) PH8 }
#if DBL_PHASE == 200
    xcd_barrier(xbar);
    PH0 xcd_barrier(xbar); PH1 xcd_barrier(xbar); PH2 xcd_barrier(xbar); PH3 xcd_barrier(xbar); PH4 xcd_barrier(xbar); PH5 xcd_barrier(xbar); PH6 xcd_barrier(xbar); PH7 xcd_barrier(xbar); PH8
#endif
    if (DBL_PHASE == 100) { for (int i = 0; i < 10; ++i) grid.sync(); }
    if (DBL_PHASE == 101) { for (int i = 0; i < 10; ++i) xcd_barrier(xbar); }
#undef IN
#undef SEAM
}

extern "C" void kernel_launch(void* const* d_in, const int* in_sizes, int n_in, void* d_out, int out_size, void* d_ws, size_t ws_size, hipStream_t stream) {
    static int grid = 0;
    if (grid == 0) {
        if (n_in != 22 || in_sizes[0] != T * DM || out_size != T * DM || ws_size < WS_END) {
            fprintf(stderr, "kernel_launch: unexpected problem (n_in %d, in0 %d, out %d, ws %zu, need %zu)\n", n_in, n_in > 0 ? in_sizes[0] : -1, out_size, ws_size, (size_t)WS_END); grid = -1; return; }
        int dev = 0, cus = 0, per_cu = 0;
        hipGetDevice(&dev); hipDeviceGetAttribute(&cus, hipDeviceAttributeMultiprocessorCount, dev);
        hipFuncSetAttribute((const void*)mega_fwd, hipFuncAttributeMaxDynamicSharedMemorySize, LDS_BYTES);
        hipOccupancyMaxActiveBlocksPerMultiprocessor(&per_cu, (const void*)mega_fwd, NTHR, LDS_BYTES);
        (void)hipGetLastError();
        if (per_cu < 1) { fprintf(stderr, "kernel_launch: occupancy query says %d blocks per CU\n", per_cu); grid = -1; return; }
        grid = cus;
    }
    if (grid < 0) return;
    if (MK_ONE_LAUNCH && GSYNC_SEAM != 0) (void)hipMemsetAsync((char*)d_ws + WS_BAR, 0, 16384, stream);
    Args a{};
    for (int i = 0; i < 22; ++i) a.in[i] = (const float*)d_in[i];
    a.out = (float*)d_out; a.ws = (unsigned char*)d_ws;
#if MK_ONE_LAUNCH
    a.ph_lo = 0; a.ph_hi = NPHASE;
    void* kargs[] = {&a};
    hipError_t e = hipLaunchCooperativeKernel((const void*)mega_fwd, dim3(grid), dim3(NTHR), kargs, LDS_BYTES, stream);
    if (e != hipSuccess) fprintf(stderr, "cooperative launch failed: %s (grid %d)\n", hipGetErrorString(e), grid);
#else
    for (int p = 0; p <= 8; ++p) {
        a.ph_lo = p; a.ph_hi = p + 1;
        hipLaunchKernelGGL(mega_fwd, dim3(grid), dim3(NTHR), LDS_BYTES, stream, a);
    }
#endif
}
```

```cpp
#include <hip/hip_runtime.h>
#include <hip/hip_cooperative_groups.h>
#include <cstdio>
#include <cstdint>
namespace cg = cooperative_groups;

#ifndef MK_ONE_LAUNCH
#define MK_ONE_LAUNCH 1
#endif
#ifndef DBL_PHASE
#define DBL_PHASE -1
#endif
#ifndef FILL_FFN_IN_P1
#define FILL_FFN_IN_P1 0
#endif
#ifndef FILL_DOWN_IN_P6
#define FILL_DOWN_IN_P6 1
#endif
#ifndef ATT_DBL
#define ATT_DBL 0
#endif
#ifndef GSYNC_SEAM
#define GSYNC_SEAM -1
#endif
#ifndef WGM_BIG
#define WGM_BIG 4
#endif
#ifndef WGM_MIX
#define WGM_MIX 4
#endif

namespace pg8 {
#define PG8_LAS __attribute__((address_space(3)))
typedef unsigned short bf16_t;
typedef short bf16x8 __attribute__((ext_vector_type(8)));
typedef float f32x4 __attribute__((ext_vector_type(4)));
typedef unsigned u32x4 __attribute__((ext_vector_type(4)));
typedef unsigned u32x2 __attribute__((ext_vector_type(2)));
constexpr int BM = 256, BK = 64, HALF = 128, HTB = HALF * BK * 2, STAGE_BYTES = 8 * HTB, NXCD = 8, WGM = 8;

__host__ __device__ __forceinline__ int lds_byte(int r, int c) { const int st = (r >> 4) * 2 + (c >> 5), rr = r & 15, cc = c & 31, ob = rr * 64 + cc * 2; return st * 1024 + (ob ^ (((ob >> 9) & 1) << 5)); }
__host__ __device__ __forceinline__ void stage_rc(int b, int& R, int& C) { const int st = b / 1024, sb = b % 1024, swz = sb ^ (((sb >> 9) & 1) << 5); R = (st >> 1) * 16 + swz / 64; C = (st & 1) * 32 + (swz % 64) / 2; }
__host__ __device__ __forceinline__ int perm32(int rho) { const int n = rho >> 4, i = rho & 15; return 8 * (i >> 2) + 4 * n + (i & 3); }

struct Unit { int pm, pn, kh; };
struct Gemm { const bf16_t* A; const bf16_t* Bt; int M, N, K, ld; size_t ksa = 0, ksb = 0; };

struct StaticOrder {
    int nM, nN, nwg, G, c, wgm = WGM;
    __host__ __device__ void init(int M, int N, int G_, int c_) { nM = M / BM; nN = N / BM; nwg = nM * nN; G = G_; c = c_; }
    __host__ __device__ bool next(int i, Unit& u) const {
        const long L = (long)i * G + c; if (L >= nwg) return false;
        int wgid = (int)L; { const int q = nwg / NXCD, r = nwg % NXCD, xcd = wgid % NXCD, off = wgid / NXCD; wgid = (xcd < r ? xcd * (q + 1) : r * (q + 1) + (xcd - r) * q) + off; }
        const int nig = wgm * nN, gid = wgid / nig, fm = gid * wgm, gsz = (nM - fm) < wgm ? (nM - fm) : wgm;
        u.pm = fm + ((wgid % nig) % gsz); u.pn = (wgid % nig) / gsz; u.kh = 0; return true;
    }
    __device__ __forceinline__ void a_ready(const Unit&) const {}
    __device__ __forceinline__ void done(const Unit&) const {}
    __host__ __device__ __forceinline__ int arow(int pm) const { return pm * BM; }
    __host__ __device__ __forceinline__ int amap(int R) const { return R; }
    __host__ __device__ __forceinline__ int ahrows() const { return HALF; }
};
struct MixOrder : StaticOrder {
    __host__ __device__ bool next(int i, Unit& u) const { if (!StaticOrder::next(i >> 1, u)) return false; u.kh = i & 1; return true; }
};
struct FfnOrder : StaticOrder {
    __host__ __device__ void init_tiles(int nM_, int nN_, int G_, int c_) { nM = nM_; nN = nN_; nwg = nM * nN; G = G_; c = c_; }
    __host__ __device__ __forceinline__ int arow(int pm) const { return 248 * pm - 2; }
    __host__ __device__ __forceinline__ int amap(int R) const { return R - 2 * (R >> 6); }
    __host__ __device__ __forceinline__ int ahrows() const { return 124; }
};

typedef float f32x2_cv __attribute__((ext_vector_type(2))); typedef __bf16 bf16x2_cv __attribute__((ext_vector_type(2)));
__device__ __forceinline__ unsigned cvt_pk_bf16(float lo, float hi) { const f32x2_cv v = {lo, hi}; const bf16x2_cv b = __builtin_convertvector(v, bf16x2_cv); return __builtin_bit_cast(unsigned, b); }

template <class Epi, class Sched, bool ALIGN_EPI = false, bool SP2 = false>
__device__ __forceinline__ void gemm_phase(PG8_LAS unsigned char* lds, const Gemm g, const Sched& S, const Epi& E) {
    const int tid = threadIdx.x, wid = __builtin_amdgcn_readfirstlane(tid >> 6), lane = tid & 63, wr = wid >> 2, wc = wid & 3, fr = lane & 15, fq = lane >> 4;
    const int K = g.K, nt = K / BK;
    unsigned voffA[2], voffB[2];
#pragma unroll
    for (int i = 0; i < 2; ++i) { int R, C; stage_rc(tid * 16 + i * 8192, R, C); const int Rb = Epi::PERM ? ((R & ~31) + perm32(R & 31)) : R;
        voffA[i] = (unsigned)(S.amap(R) * g.ld + C) * 2u; voffB[i] = (unsigned)(Rb * g.ld + C) * 2u; }
    const size_t kstepA = g.ksa ? g.ksa : (size_t)(BK * 2), kstepB = g.ksb ? g.ksb : (size_t)(BK * 2);
    const size_t hstep = (size_t)HALF * g.ld * 2, hstepA = (size_t)S.ahrows() * g.ld * 2;
    const size_t tstep = 2 * hstep;
    const unsigned ldsw = (unsigned)wid * 1024u;
    const int aoff = lds_byte(wr * 64 + fr, fq * 8), boff = lds_byte(wc * 32 + fr, fq * 8);
#define PG8_SA(b, h) (((b) * 2 + (h)) * HTB)
#define PG8_SB(b, h) ((4 + (b) * 2 + (h)) * HTB)
#define PG8_STAGE(bufoff, gbase, voff) do { _Pragma("unroll") for (int _i = 0; _i < 2; ++_i) \
        __builtin_amdgcn_global_load_lds((const unsigned*)((const char*)(gbase) + (voff)[_i]), (PG8_LAS unsigned*)(lds + (bufoff) + ldsw + _i * 8192), 16, 0, 0); } while (0)
#define PG8_LDA(dst, b, h) do { _Pragma("unroll") for (int m = 0; m < 4; ++m) _Pragma("unroll") for (int k = 0; k < 2; ++k) dst[m][k] = *(const PG8_LAS bf16x8*)(lds + PG8_SA(b, h) + aoff + m * 2048 + k * 1024); } while (0)
#define PG8_LDB(dst, b, h) do { _Pragma("unroll") for (int n = 0; n < 2; ++n) _Pragma("unroll") for (int k = 0; k < 2; ++k) dst[n][k] = *(const PG8_LAS bf16x8*)(lds + PG8_SB(b, h) + boff + n * 2048 + k * 1024); } while (0)
#define PG8_MMA(ai, bj, At, Bt) do { __builtin_amdgcn_s_setprio(1); _Pragma("unroll") for (int m = 0; m < 4; ++m) _Pragma("unroll") for (int n = 0; n < 2; ++n) _Pragma("unroll") for (int k = 0; k < 2; ++k) \
        acc[ai][bj][m][n] = __builtin_amdgcn_mfma_f32_16x16x32_bf16(Bt[n][k], At[m][k], acc[ai][bj][m][n], 0, 0, 0); __builtin_amdgcn_s_setprio(0); } while (0)
#define PG8_WAIT_V(n) asm volatile("s_waitcnt vmcnt(" #n ")" ::: "memory")
#define PG8_WAIT_L(n) asm volatile("s_waitcnt lgkmcnt(" #n ")" ::: "memory")
#define PG8_BAR __builtin_amdgcn_s_barrier()
#define PG8_SCHED __builtin_amdgcn_sched_barrier(0)
    Unit cur, nxt; int ui = 0;
    if (!S.next(0, cur)) return;
    f32x4 acc[2][2][4][2];
#pragma unroll
    for (int a = 0; a < 2; ++a)
#pragma unroll
        for (int b = 0; b < 2; ++b)
#pragma unroll
            for (int m = 0; m < 4; ++m)
#pragma unroll
                for (int n = 0; n < 2; ++n) acc[a][b][m][n] = (f32x4){0.f, 0.f, 0.f, 0.f};
    bf16x8 At[4][2], B0[2][2], B1[2][2];
    const size_t rstep = (size_t)g.ld * 2, khstep = (size_t)K * 2;
    const char* cA = (const char*)g.A + (ptrdiff_t)S.arow(cur.pm) * (ptrdiff_t)rstep + cur.kh * khstep; const char* cB = (const char*)g.Bt + (size_t)cur.pn * tstep + cur.kh * khstep;
    S.a_ready(cur);
    if constexpr (SP2) {
        PG8_STAGE(PG8_SB(0, 0), cB, voffB); PG8_STAGE(PG8_SB(0, 1), cB + hstep, voffB); PG8_STAGE(PG8_SA(0, 0), cA, voffA); PG8_STAGE(PG8_SA(0, 1), cA + hstepA, voffA);
        if (wr == 1) PG8_BAR;
        PG8_WAIT_V(2); PG8_BAR;
        PG8_STAGE(PG8_SB(1, 0), cB + kstepB, voffB); PG8_STAGE(PG8_SA(1, 0), cA + kstepA, voffA); PG8_STAGE(PG8_SB(1, 1), cB + hstep + kstepB, voffB);
        PG8_WAIT_V(6); PG8_BAR;
    } else {
        PG8_STAGE(PG8_SB(0, 0), cB, voffB); PG8_STAGE(PG8_SA(0, 0), cA, voffA); PG8_STAGE(PG8_SB(0, 1), cB + hstep, voffB); PG8_STAGE(PG8_SA(0, 1), cA + hstepA, voffA);
        if (wr == 1) PG8_BAR;
        PG8_WAIT_V(4); PG8_BAR;
        PG8_STAGE(PG8_SB(1, 0), cB + kstepB, voffB); PG8_STAGE(PG8_SA(1, 0), cA + kstepA, voffA); PG8_STAGE(PG8_SB(1, 1), cB + hstep + kstepB, voffB);
        PG8_WAIT_V(6); PG8_BAR;
    }
    for (;;) {
        const bool has_next = S.next(ui + 1, nxt);
        const char* nA = has_next ? (const char*)g.A + (ptrdiff_t)S.arow(nxt.pm) * (ptrdiff_t)rstep + nxt.kh * khstep : cA; const char* nB = has_next ? (const char*)g.Bt + (size_t)nxt.pn * tstep + nxt.kh * khstep : cB;
        for (int t = 0; t < nt; t += 2) {
            const bool last = (t == nt - 2);
            const char* a1 = cA + (size_t)(t + 1) * kstepA;
            const char* a2 = last ? nA : cA + (size_t)(t + 2) * kstepA; const char* b2 = last ? nB : cB + (size_t)(t + 2) * kstepB;
            const char* a3 = a2 + kstepA; const char* b3 = b2 + kstepB;
            if (last && has_next) S.a_ready(nxt);
            if constexpr (SP2) {
            PG8_LDB(B0, 0, 0); PG8_LDB(B1, 0, 1); PG8_SCHED; PG8_LDA(At, 0, 0); PG8_STAGE(PG8_SA(1, 1), a1 + hstepA, voffA);
            PG8_WAIT_V(8); PG8_WAIT_L(0); PG8_BAR; PG8_MMA(0, 0, At, B0); PG8_MMA(0, 1, At, B1); PG8_BAR; PG8_SCHED;
            PG8_LDA(At, 0, 1); PG8_STAGE(PG8_SB(0, 0), b2, voffB); PG8_STAGE(PG8_SB(0, 1), b2 + hstep, voffB); PG8_STAGE(PG8_SA(0, 0), a2, voffA);
            PG8_WAIT_V(8); PG8_WAIT_L(0); PG8_BAR; PG8_MMA(1, 0, At, B0); PG8_MMA(1, 1, At, B1); PG8_BAR; PG8_SCHED;
            PG8_LDB(B0, 1, 0); PG8_LDB(B1, 1, 1); PG8_SCHED; PG8_LDA(At, 1, 0); PG8_STAGE(PG8_SA(0, 1), a2 + hstepA, voffA);
            PG8_WAIT_V(8); PG8_WAIT_L(0); PG8_BAR; PG8_MMA(0, 0, At, B0); PG8_MMA(0, 1, At, B1); PG8_BAR; PG8_SCHED;
            PG8_LDA(At, 1, 1); PG8_STAGE(PG8_SB(1, 0), b3, voffB); PG8_STAGE(PG8_SB(1, 1), b3 + hstep, voffB); PG8_STAGE(PG8_SA(1, 0), a3, voffA);
            PG8_WAIT_V(8); PG8_WAIT_L(0); PG8_BAR; PG8_MMA(1, 0, At, B0); PG8_MMA(1, 1, At, B1); PG8_BAR; PG8_SCHED;
            } else {
            PG8_LDB(B0, 0, 0); PG8_SCHED; PG8_LDA(At, 0, 0); PG8_STAGE(PG8_SA(1, 1), a1 + hstepA, voffA);
            PG8_WAIT_L(8); PG8_BAR; PG8_WAIT_L(0); PG8_MMA(0, 0, At, B0); PG8_BAR; PG8_SCHED;
            PG8_LDB(B1, 0, 1); PG8_STAGE(PG8_SB(0, 0), b2, voffB);
            PG8_BAR; PG8_WAIT_L(0); PG8_MMA(0, 1, At, B1); PG8_BAR;
            PG8_LDA(At, 0, 1); PG8_STAGE(PG8_SA(0, 0), a2, voffA);
            PG8_BAR; PG8_WAIT_L(0); PG8_MMA(1, 0, At, B0); PG8_BAR; PG8_SCHED;
            PG8_STAGE(PG8_SB(0, 1), b2 + hstep, voffB);
            PG8_WAIT_V(6); PG8_BAR; PG8_MMA(1, 1, At, B1); PG8_BAR;
            PG8_LDB(B0, 1, 0); PG8_SCHED; PG8_LDA(At, 1, 0); PG8_STAGE(PG8_SA(0, 1), a2 + hstepA, voffA);
            PG8_WAIT_L(8); PG8_BAR; PG8_WAIT_L(0); PG8_MMA(0, 0, At, B0); PG8_BAR; PG8_SCHED;
            PG8_LDB(B1, 1, 1); PG8_STAGE(PG8_SB(1, 0), b3, voffB);
            PG8_BAR; PG8_WAIT_L(0); PG8_MMA(0, 1, At, B1); PG8_BAR;
            PG8_LDA(At, 1, 1); PG8_STAGE(PG8_SA(1, 0), a3, voffA);
            PG8_BAR; PG8_WAIT_L(0); PG8_MMA(1, 0, At, B0); PG8_BAR; PG8_SCHED;
            PG8_STAGE(PG8_SB(1, 1), b3 + hstep, voffB);
            PG8_WAIT_V(6); PG8_BAR; PG8_MMA(1, 1, At, B1); PG8_BAR;
            }
        }
        if constexpr (ALIGN_EPI) { if (wr == 0) PG8_BAR; }
        if constexpr (Epi::USES_LDS) E(acc, cur, wr, wc, fr, fq, lds, S); else E(acc, cur, wr, wc, fr, fq);
        S.done(cur);
        if (!has_next) break;
        if (!(Epi::HAS_MID && cur.kh == 0)) {
#pragma unroll
        for (int a = 0; a < 2; ++a)
#pragma unroll
            for (int b = 0; b < 2; ++b)
#pragma unroll
                for (int m = 0; m < 4; ++m)
#pragma unroll
                    for (int n = 0; n < 2; ++n) acc[a][b][m][n] = (f32x4){0.f, 0.f, 0.f, 0.f};
        }
        cur = nxt; cA = nA; cB = nB; ++ui;
        if constexpr (ALIGN_EPI) { if (wr == 1) PG8_BAR; }
    }
    PG8_WAIT_V(0);
    if constexpr (!ALIGN_EPI) { if (wr == 0) PG8_BAR; }
    PG8_BAR;
#undef PG8_SA
#undef PG8_SB
#undef PG8_STAGE
#undef PG8_LDA
#undef PG8_LDB
#undef PG8_MMA
#undef PG8_WAIT_V
#undef PG8_WAIT_L
#undef PG8_BAR
#undef PG8_SCHED
}
}

typedef unsigned short bf16;
typedef float f32x4 __attribute__((ext_vector_type(4)));
typedef unsigned u32x4 __attribute__((ext_vector_type(4)));
typedef unsigned u32x2 __attribute__((ext_vector_type(2)));
constexpr int T = 8192, DM = 2048, NH = 8, HD = 128, NKV = 2, QW = 1024, KVW = 256, SGW = 1024, DFF = 5504;
constexpr int INW = 8728, NP0 = 8960, NP0M = 8192;
constexpr int NWAVES = 8, NTHR = 512;
constexpr float NORM_EPS = 1e-6f, LN_EPS = 1e-5f;
constexpr float QSCALE = 0.08838834764831845f * 1.4426950408889634f;
constexpr float LOG2E = 1.4426950408889634f, LN2 = 0.6931471805599453f;

constexpr size_t MiB = 1u << 20;
constexpr size_t WS_WFFN = 0;
constexpr size_t WS_WDOWN = 43 * MiB;
constexpr size_t WS_H = WS_WDOWN + 43 * MiB / 2;
constexpr size_t WS_O = WS_H + 32 * MiB;
constexpr size_t WS_WIN = WS_O;
constexpr size_t WS_Q = WS_WIN + 35 * MiB;
constexpr size_t WS_KV = WS_Q + 16 * MiB;
constexpr size_t WS_U = WS_KV + 24 * MiB;
constexpr size_t WS_V = WS_U + 16 * MiB;
constexpr size_t WS_GA = WS_V + 16 * MiB;
constexpr size_t WS_GB = WS_GA + 32 * MiB;
constexpr size_t WS_NSAG = WS_GB + 32 * MiB;
constexpr size_t WS_A = WS_O;
constexpr size_t WS_B = WS_A + 86 * MiB;
constexpr size_t WS_G = WS_A;
constexpr size_t WS_MIXED = WS_Q;
constexpr size_t WS_TA = WS_U;
constexpr size_t WS_YA = WS_O + 172 * MiB;
constexpr size_t WS_YB = WS_YA + 2048;
constexpr int YLD = 2048;
constexpr size_t WS_WOUT = WS_YA + 32 * MiB;
constexpr size_t WS_WPA = WS_WOUT + 8 * MiB;
constexpr size_t WS_WPB = WS_WPA + 2048;
constexpr size_t WS_KC = WS_WPA + 8 * MiB;
constexpr size_t WS_P2 = WS_KC + 1 * MiB;
constexpr size_t WS_P3 = WS_P2 + 1 * MiB;
constexpr size_t WS_BAR = WS_P3 + 1 * MiB;
constexpr size_t WS_RINV = WS_BAR + 256 * 1024;
constexpr size_t WS_CONVP = WS_BAR + 512 * 1024;
constexpr size_t WS_W1T = WS_BAR + 1 * MiB;
constexpr size_t WS_W2T = WS_W1T + 2 * MiB;
constexpr size_t WS_VSTAT = WS_W2T + 1 * MiB;
constexpr size_t WS_END = WS_VSTAT + 1 * MiB;
static_assert(WS_NSAG + (size_t)T * 24 * 4 <= WS_O + 172 * MiB && WS_B + 86 * MiB == WS_O + 172 * MiB, "overlay map");

constexpr int LDS_BYTES = 147456;

__device__ __forceinline__ float bf2f(unsigned short b) { return __uint_as_float(((unsigned)b) << 16); }
__device__ __forceinline__ float bflo(unsigned w) { return __uint_as_float(w << 16); }
__device__ __forceinline__ float bfhi(unsigned w) { return __uint_as_float(w & 0xffff0000u); }
__device__ __forceinline__ unsigned f2bf(float f) { unsigned u = __float_as_uint(f); return (u + 0x7fffu + ((u >> 16) & 1u)) >> 16; }
__device__ __forceinline__ unsigned pk2(float lo, float hi) { return pg8::cvt_pk_bf16(lo, hi); }
__device__ __forceinline__ float gelu_t(float x) {
    const float e = __builtin_amdgcn_exp2f(x * fmaf(x * x, -0.10294324f, -2.3022082f));
    return x * __builtin_amdgcn_rcpf(1.0f + e);
}
__device__ __forceinline__ float sigmoid_f(float x) { return __builtin_amdgcn_rcpf(1.0f + __builtin_amdgcn_exp2f(x * -1.4426950408889634f)); }
__device__ __forceinline__ float lane_xor16(float v) { auto rr = __builtin_amdgcn_permlane16_swap(__float_as_uint(v), __float_as_uint(v), false, false); return (threadIdx.x & 16) ? __uint_as_float(rr[0]) : __uint_as_float(rr[1]); }
__device__ __forceinline__ float lane_xor32(float v) { auto rr = __builtin_amdgcn_permlane32_swap(__float_as_uint(v), __float_as_uint(v), false, false); return (threadIdx.x & 32) ? __uint_as_float(rr[0]) : __uint_as_float(rr[1]); }
__device__ __forceinline__ float wave_sum(float v) {
#pragma unroll
    for (int o = 1; o < 64; o <<= 1) v += __shfl_xor(v, o);
    return v;
}
__device__ __forceinline__ float wave_max(float v) {
#pragma unroll
    for (int o = 1; o < 64; o <<= 1) v = fmaxf(v, __shfl_xor(v, o));
    return v;
}

struct Args {
    const float* in[22];
    float* out;
    unsigned char* ws;
    int ph_lo, ph_hi;
};


#define XB_TMO      128
#define XB_XCNT(j)  (256  + 64 * (j))
#define XB_XSUB(j)  (1280 + 64 * (j))
#define XB_XGEN(j)  (2304 + 64 * (j))
#define XB_TOP      3328
#define XB_TOPGEN   3392
#define XCD_BAR_WORDS 3456
#define XB_SPIN_CAP (1u << 22)
__device__ __forceinline__ unsigned xb_ld(unsigned* p)              { return __hip_atomic_load(p, __ATOMIC_RELAXED, __HIP_MEMORY_SCOPE_AGENT); }
__device__ __forceinline__ unsigned xb_add(unsigned* p, unsigned v) { return __hip_atomic_fetch_add(p, v, __ATOMIC_RELAXED, __HIP_MEMORY_SCOPE_AGENT); }
__device__ __forceinline__ unsigned xb_xcc_id() { return (unsigned)__builtin_amdgcn_s_getreg((3 << 11) | 20) & 0xFu; }
#define XB_SPIN(cond, bar) do { unsigned _sp = 0; while (cond) { __builtin_amdgcn_s_sleep(1); \
    if ((++_sp & 255u) == 0u) { if (xb_ld(&(bar)[XB_TMO])) break; if (_sp > XB_SPIN_CAP) { atomicAdd(&(bar)[XB_TMO], 1u); break; } } } } while (0)
struct XcdBarrier { unsigned* bar; unsigned x; volatile __attribute__((address_space(3))) unsigned* st; };
__device__ __forceinline__ XcdBarrier xcd_barrier_post(unsigned* bar, volatile __attribute__((address_space(3))) unsigned* st) {
    XcdBarrier b; b.bar = bar; b.x = xb_xcc_id(); b.st = st;
    if (threadIdx.x == 0) (void)xb_add(&bar[XB_XCNT(b.x)], 1u);
    return b;
}
__device__ __forceinline__ void xcd_barrier_complete(unsigned* bar, unsigned x, unsigned& nloc, unsigned& nx) {
    const unsigned G = gridDim.x * gridDim.y * gridDim.z;
    unsigned sum, cnt, mine, sp = 0u;
    for (;;) {
        sum = 0u; cnt = 0u; mine = 0u;
#pragma unroll
        for (unsigned j = 0; j < 16; ++j) { const unsigned c = xb_ld(&bar[XB_XCNT(j)]); sum += c; cnt += (c > 0u) ? 1u : 0u; mine = (j == x) ? c : mine; }
        if (sum == G) break;
        __builtin_amdgcn_s_sleep(1);
        if ((++sp & 255u) == 0u) { if (xb_ld(&bar[XB_TMO])) break; if (sp > XB_SPIN_CAP) { atomicAdd(&bar[XB_TMO], 1u); break; } }
    }
    nloc = mine > 0u ? mine : 1u; nx = cnt > 0u ? cnt : 1u;
}
__device__ __forceinline__ void xcd_barrier(const XcdBarrier& b) {
    asm volatile("s_waitcnt vmcnt(0)" ::: "memory");
    __syncthreads();
    if (threadIdx.x == 0) {
        unsigned* bar = b.bar;
        __builtin_amdgcn_s_waitcnt(0);
        unsigned nloc = b.st[0], nx = b.st[1];
        if (nloc == 0u) { xcd_barrier_complete(bar, b.x, nloc, nx); b.st[0] = nloc; b.st[1] = nx; }
        const unsigned old = xb_add(&bar[XB_XSUB(b.x)], 1u);
        const unsigned gen = old / nloc;
        if (old + 1u == (gen + 1u) * nloc) {
            __builtin_amdgcn_fence(__ATOMIC_RELEASE, "agent");
            asm volatile("s_waitcnt vmcnt(0)" ::: "memory");
            const unsigned og = xb_add(&bar[XB_TOP], 1u);
            const unsigned tg = og / nx;
            if (og + 1u != (tg + 1u) * nx) XB_SPIN(xb_ld(&bar[XB_TOP]) < (tg + 1u) * nx, bar);
            __builtin_amdgcn_fence(__ATOMIC_ACQUIRE, "agent");
            xb_add(&bar[XB_XGEN(b.x)], 1u);
            asm volatile("s_waitcnt vmcnt(0)" ::: "memory");
        } else {
            XB_SPIN(xb_ld(&bar[XB_XGEN(b.x)]) == gen, bar);
            __builtin_amdgcn_fence(__ATOMIC_ACQUIRE, "agent");
            asm volatile("s_waitcnt vmcnt(0)" ::: "memory");
        }
    }
    __syncthreads();
}

using pg8::Unit;
constexpr float GB_MIN = 1.0e-6f;
struct Epi0 {
    static constexpr bool PERM = true, AFTER_DRAIN = false, HAS_MID = false, USES_LDS = false;
    unsigned char* ws; int pn_off;
    template <int ACT> __device__ __forceinline__ void store(const f32x4 (&acc)[2][2][4][2], bf16* base, int ldc, int colbase, const Unit& u, int wr, int wc, int fr, int fq) const {
        const int row0 = u.pm * 256 + wr * 64 + fr, col0 = colbase + wc * 32 + 8 * fq;
#pragma unroll
        for (int ai = 0; ai < 2; ++ai)
#pragma unroll
            for (int m = 0; m < 4; ++m) { bf16* rowp = base + (size_t)(row0 + ai * 128 + m * 16) * ldc + col0;
#pragma unroll
                for (int bj = 0; bj < 2; ++bj) { u32x4 w;
#pragma unroll
                    for (int n = 0; n < 2; ++n) { f32x4 v = acc[ai][bj][m][n];
                        if (ACT == 0) { v = v * QSCALE; }
                        if (ACT == 2) { v[0] = gelu_t(v[0]); v[1] = gelu_t(v[1]); v[2] = gelu_t(v[2]); v[3] = gelu_t(v[3]); }
                        if (ACT == 3) { v[0] = sigmoid_f(v[0]); v[1] = sigmoid_f(v[1]); v[2] = sigmoid_f(v[2]); v[3] = sigmoid_f(v[3]); }
                        if (n == 0) { w.x = pk2(v[0], v[1]); w.y = pk2(v[2], v[3]); } else { w.z = pk2(v[0], v[1]); w.w = pk2(v[2], v[3]); } }
                    *(u32x4*)(rowp + bj * 128) = w; } }
    }
    __device__ __forceinline__ void operator()(const f32x4 (&acc)[2][2][4][2], const Unit& u, int wr, int wc, int fr, int fq) const {
        const int pn = u.pn + pn_off;
        if (pn < 4) store<0>(acc, (bf16*)(ws + WS_Q), 1024, pn * 256, u, wr, wc, fr, fq);
        else if (pn < 6) {
            bf16* base = (bf16*)(ws + WS_KV) + (size_t)(pn - 4) * T * 256; const int row0 = u.pm * 256 + wr * 64 + fr;
#pragma unroll
            for (int ai = 0; ai < 2; ++ai)
#pragma unroll
                for (int m = 0; m < 4; ++m)
#pragma unroll
                    for (int bj = 0; bj < 2; ++bj) { const f32x4 v0 = acc[ai][bj][m][0], v1 = acc[ai][bj][m][1]; u32x4 w; w.x = pk2(v0[0], v0[1]); w.y = pk2(v0[2], v0[3]); w.z = pk2(v1[0], v1[1]); w.w = pk2(v1[2], v1[3]);
                        *(u32x4*)(base + (size_t)bj * T * 128 + (size_t)(row0 + ai * 128 + m * 16) * 128 + wc * 32 + 8 * fq) = w; }
        }
        else if (pn < 10) store<1>(acc, (bf16*)(ws + WS_KV) + (size_t)(pn - 4) * T * 256, 256, 0, u, wr, wc, fr, fq);
        else if (pn < 14) store<2>(acc, (bf16*)(ws + WS_U), 1024, (pn - 10) * 256, u, wr, wc, fr, fq);
        else if (pn < 18) {
            bf16* base = (bf16*)(ws + WS_V); float* vs = (float*)(ws + WS_VSTAT); const int row0 = u.pm * 256 + wr * 64 + fr, col0 = (pn - 14) * 256 + wc * 32 + 8 * fq;
#pragma unroll
            for (int ai = 0; ai < 2; ++ai)
#pragma unroll
                for (int m = 0; m < 4; ++m) { const int row = row0 + ai * 128 + m * 16; bf16* rowp = base + (size_t)row * 1024 + col0; float s1 = 0.f, s2 = 0.f;
#pragma unroll
                    for (int bj = 0; bj < 2; ++bj) { u32x4 w;
#pragma unroll
                        for (int n = 0; n < 2; ++n) { const f32x4 v = acc[ai][bj][m][n];
                            const float q0 = gelu_t(v[0]), q1 = gelu_t(v[1]), q2 = gelu_t(v[2]), q3 = gelu_t(v[3]);
                            s1 += (q0 + q1) + (q2 + q3); s2 += (q0 * q0 + q1 * q1) + (q2 * q2 + q3 * q3);
                            if (n == 0) { w.x = pk2(q0, q1); w.y = pk2(q2, q3); } else { w.z = pk2(q0, q1); w.w = pk2(q2, q3); } }
                        *(u32x4*)(rowp + bj * 128) = w; }
                    s1 += lane_xor16(s1); s1 += lane_xor32(s1); s2 += lane_xor16(s2); s2 += lane_xor32(s2);
                    if (fq == 0) { float* o = vs + ((size_t)row * 16 + (pn - 14) * 4 + wc) * 2; o[0] = s1; o[1] = s2; }
                    asm volatile("" ::: "memory"); }
        }
        else if (pn != 31) {
            const int k = pn < 31 ? pn - 18 : pn - 19; bf16* gr = (bf16*)(ws + WS_GA); bf16* gs = (bf16*)(ws + WS_GB);
            const int row0 = u.pm * 256 + wr * 64 + fr, col0 = 128 * k + wc * 32 + 8 * fq;
#pragma unroll
            for (int ai = 0; ai < 2; ++ai)
#pragma unroll
                for (int m = 0; m < 4; ++m) { const size_t o = (size_t)(row0 + ai * 128 + m * 16) * 2048 + col0; u32x4 wr_, ws_;
#pragma unroll
                    for (int n = 0; n < 2; ++n) { const f32x4 a = acc[ai][0][m][n], b = acc[ai][1][m][n]; float r[4], sb[4];
#pragma unroll
                        for (int e = 0; e < 4; ++e) { sb[e] = fmaxf(sigmoid_f(b[e]), GB_MIN); r[e] = sigmoid_f(a[e]) * __builtin_amdgcn_rcpf(sb[e]); }
                        if (n == 0) { wr_.x = pk2(r[0], r[1]); wr_.y = pk2(r[2], r[3]); ws_.x = pk2(sb[0], sb[1]); ws_.y = pk2(sb[2], sb[3]); }
                        else { wr_.z = pk2(r[0], r[1]); wr_.w = pk2(r[2], r[3]); ws_.z = pk2(sb[0], sb[1]); ws_.w = pk2(sb[2], sb[3]); } }
                    *(u32x4*)(gr + o) = wr_; *(u32x4*)(gs + o) = ws_; }
        }
        else {
            float* ng = (float*)(ws + WS_NSAG);
            if (wc == 0) {
                const int row0 = u.pm * 256 + wr * 64 + fr;
#pragma unroll
                for (int ai = 0; ai < 2; ++ai)
#pragma unroll
                    for (int m = 0; m < 4; ++m)
#pragma unroll
                        for (int n = 0; n < 2; ++n) { const int c = 8 * fq + 4 * n;
                            if (c < 24) { f32x4 v = acc[ai][0][m][n]; f32x4 o; o[0] = sigmoid_f(v[0]); o[1] = sigmoid_f(v[1]); o[2] = sigmoid_f(v[2]); o[3] = sigmoid_f(v[3]);
                                *(f32x4*)(ng + (size_t)(row0 + ai * 128 + m * 16) * 24 + c) = o; } }
            }
        }
    }
};
struct EpiMix {
    static constexpr bool PERM = true, AFTER_DRAIN = false, HAS_MID = true, USES_LDS = false;
    const bf16* ga; const bf16* gb; bf16* out;
    __device__ __forceinline__ void operator()(f32x4 (&acc)[2][2][4][2], const Unit& u, int wr, int wc, int fr, int fq) const {
        const int row0 = u.pm * 256 + wr * 64 + fr, col0 = u.pn * 256 + wc * 32 + 8 * fq;
        if (u.kh == 0) {
#pragma unroll
            for (int ai = 0; ai < 2; ++ai)
#pragma unroll
                for (int m = 0; m < 4; ++m) { const size_t ro = (size_t)(row0 + ai * 128 + m * 16) * 2048 + col0;
#pragma unroll
                    for (int bj = 0; bj < 2; ++bj) { const size_t o = ro + bj * 128; const u32x4 aw = *(const u32x4*)(ga + o);
#pragma unroll
                        for (int n = 0; n < 2; ++n) { const unsigned a0 = n ? aw.z : aw.x, a1 = n ? aw.w : aw.y;
                            f32x4 v = acc[ai][bj][m][n];
                            v[0] *= bflo(a0); v[1] *= bfhi(a0); v[2] *= bflo(a1); v[3] *= bfhi(a1);
                            acc[ai][bj][m][n] = v; } }
                    asm volatile("" ::: "memory"); }
        } else {
#pragma unroll
            for (int ai = 0; ai < 2; ++ai)
#pragma unroll
                for (int m = 0; m < 4; ++m) { const size_t ro = (size_t)(row0 + ai * 128 + m * 16) * 2048 + col0;
#pragma unroll
                    for (int bj = 0; bj < 2; ++bj) { const size_t o = ro + bj * 128; const u32x4 gw = *(const u32x4*)(gb + o); u32x4 w;
#pragma unroll
                        for (int n = 0; n < 2; ++n) { const f32x4 v = acc[ai][bj][m][n]; const unsigned g0 = n ? gw.z : gw.x, g1 = n ? gw.w : gw.y;
                            const unsigned w0 = pk2(v[0] * bflo(g0), v[1] * bfhi(g0)), w1 = pk2(v[2] * bflo(g1), v[3] * bfhi(g1));
                            if (n == 0) { w.x = w0; w.y = w1; } else { w.z = w0; w.w = w1; } }
                        *(u32x4*)(out + o) = w; } }
        }
    }
};
struct EpiRes {
    static constexpr bool PERM = true, AFTER_DRAIN = false, HAS_MID = false, USES_LDS = false;
    const float* rinv; bf16* xb; float* part;
    __device__ __forceinline__ void operator()(const f32x4 (&acc)[2][2][4][2], const Unit& u, int wr, int wc, int fr, int fq) const {
        const int row0 = u.pm * 256 + wr * 64 + fr, col0 = u.pn * 256 + wc * 32 + 8 * fq;
#pragma unroll
        for (int ai = 0; ai < 2; ++ai)
#pragma unroll
            for (int m = 0; m < 4; ++m) { const int row = row0 + ai * 128 + m * 16; const size_t ro = (size_t)row * 2048 + col0; float ss = 0.f; const float ri = rinv[row];
#pragma unroll
                for (int bj = 0; bj < 2; ++bj) { const u32x4 hw = *(const u32x4*)(xb + ro + bj * 128); u32x4 w;
#pragma unroll
                    for (int n = 0; n < 2; ++n) { const unsigned h0 = n ? hw.z : hw.x, h1 = n ? hw.w : hw.y;
                        f32x4 v = acc[ai][bj][m][n]; v[0] = fmaf(bflo(h0), ri, v[0]); v[1] = fmaf(bfhi(h0), ri, v[1]); v[2] = fmaf(bflo(h1), ri, v[2]); v[3] = fmaf(bfhi(h1), ri, v[3]);
                        ss += (v[0] * v[0] + v[1] * v[1]) + (v[2] * v[2] + v[3] * v[3]);
                        if (n == 0) { w.x = pk2(v[0], v[1]); w.y = pk2(v[2], v[3]); } else { w.z = pk2(v[0], v[1]); w.w = pk2(v[2], v[3]); } }
                    *(u32x4*)(xb + ro + bj * 128) = w; }
                ss += lane_xor16(ss); ss += lane_xor32(ss);
                if (fq == 0) part[(size_t)row * 32 + u.pn * 4 + wc] = ss; }
    }
};
struct EpiResB {
    static constexpr bool PERM = true, AFTER_DRAIN = false, HAS_MID = false, USES_LDS = false;
    bf16* xb; float* part;
    __device__ __forceinline__ void operator()(const f32x4 (&acc)[2][2][4][2], const Unit& u, int wr, int wc, int fr, int fq) const {
        const int row0 = u.pm * 256 + wr * 64 + fr, col0 = u.pn * 256 + wc * 32 + 8 * fq;
#pragma unroll
        for (int ai = 0; ai < 2; ++ai)
#pragma unroll
            for (int m = 0; m < 4; ++m) { const int row = row0 + ai * 128 + m * 16; const size_t ro = (size_t)row * 2048 + col0; float ss = 0.f;
#pragma unroll
                for (int bj = 0; bj < 2; ++bj) { const size_t o = ro + bj * 128; const u32x4 xw = *(const u32x4*)(xb + o); u32x4 w;
#pragma unroll
                    for (int n = 0; n < 2; ++n) { const unsigned x0 = n ? xw.z : xw.x, x1 = n ? xw.w : xw.y;
                        f32x4 v = acc[ai][bj][m][n]; v[0] += bflo(x0); v[1] += bfhi(x0); v[2] += bflo(x1); v[3] += bfhi(x1);
                        ss += (v[0] * v[0] + v[1] * v[1]) + (v[2] * v[2] + v[3] * v[3]);
                        if (n == 0) { w.x = pk2(v[0], v[1]); w.y = pk2(v[2], v[3]); } else { w.z = pk2(v[0], v[1]); w.w = pk2(v[2], v[3]); } }
                    *(u32x4*)(xb + o) = w; }
                ss += lane_xor16(ss); ss += lane_xor32(ss);
                if (fq == 0) part[(size_t)row * 32 + u.pn * 4 + wc] = ss; }
    }
};
template <int CTRL> __device__ __forceinline__ float dpp_z(float v) { return __uint_as_float((unsigned)__builtin_amdgcn_update_dpp(0, (int)__float_as_uint(v), CTRL, 0xF, 0xF, true)); }
template <int CTRL> __device__ __forceinline__ float dpp_m(float old, float v) { return __uint_as_float((unsigned)__builtin_amdgcn_update_dpp((int)__float_as_uint(old), (int)__float_as_uint(v), CTRL, 0xF, 0xF, false)); }
#define DPP_SHR1 0x111
#define DPP_SHR2 0x112
#define DPP_SHL14 0x10E
#define DPP_SHL15 0x10F
struct EpiFfnConv {
    static constexpr bool PERM = true, AFTER_DRAIN = false, HAS_MID = false, USES_LDS = false;
    const float* part; const u32x2* cwp; bf16* gout;
    __device__ __forceinline__ void operator()(f32x4 (&acc)[2][2][4][2], const Unit& u, int wr, int wc, int fr_in, int fq_in) const {
        int fr = fr_in, fq = fq_in; asm volatile("" : "+v"(fr), "+v"(fq));
        const int j = u.pn * 128 + wc * 32 + 8 * fq;
        u32x4 cw[2][2];
#pragma unroll
        for (int n = 0; n < 2; ++n) { cw[n][0] = *(const u32x4*)(cwp + j + 4 * n); cw[n][1] = *(const u32x4*)(cwp + j + 4 * n + 2); }
#pragma unroll
        for (int ai = 0; ai < 2; ++ai) { const int rbase = 62 * (4 * u.pm + 2 * ai + wr) - 2 + fr;
#pragma unroll
            for (int m = 0; m < 4; ++m) { int row = rbase + 16 * m; row = row < 0 ? 0 : (row > T - 1 ? T - 1 : row);
                const f32x4 p0 = *(const f32x4*)(part + (size_t)row * 32 + fq * 8), p1 = *(const f32x4*)(part + (size_t)row * 32 + fq * 8 + 4);
                float ss = ((p0[0] + p0[1]) + (p0[2] + p0[3])) + ((p1[0] + p1[1]) + (p1[2] + p1[3]));
                ss += lane_xor16(ss); ss += lane_xor32(ss);
                const float r = rsqrtf(ss * (1.0f / 2048.0f) + NORM_EPS);
#pragma unroll
                for (int bj = 0; bj < 2; ++bj)
#pragma unroll
                    for (int n = 0; n < 2; ++n) acc[ai][bj][m][n] = acc[ai][bj][m][n] * r; } }
        if (u.pm == 0 && wr == 0 && fr < 2) { acc[0][0][0][0] = (f32x4){0.f, 0.f, 0.f, 0.f}; acc[0][0][0][1] = (f32x4){0.f, 0.f, 0.f, 0.f}; }
        bf16* gcol = gout + (size_t)(j >> 6) * (T * 64) + (j & 63);
#pragma unroll
        for (int ai = 0; ai < 2; ++ai) { int rbase = 62 * (4 * u.pm + 2 * ai + wr) - 2 + fr; asm volatile("" : "+v"(rbase));
            u32x2 half[4];
#pragma unroll
            for (int n = 0; n < 2; ++n) {
                float t0[4], t1[4], t2[4], tb[4];
#pragma unroll
                for (int e = 0; e < 4; ++e) { const unsigned c01 = cw[n][e >> 1][2 * (e & 1)], c2b = cw[n][e >> 1][2 * (e & 1) + 1]; t0[e] = bflo(c01); t1[e] = bfhi(c01); t2[e] = bflo(c2b); tb[e] = bfhi(c2b); }
#pragma unroll
                for (int m = 0; m < 4; ++m) {
                    const f32x4 cur = acc[ai][0][m][n]; f32x4 o;
#pragma unroll
                    for (int e = 0; e < 4; ++e) {
                        float z1, z2;
                        if (m > 0) { const float pm_ = acc[ai][0][m - 1][n][e]; z1 = dpp_m<DPP_SHR1>(dpp_z<DPP_SHL15>(pm_), cur[e]); z2 = dpp_m<DPP_SHR2>(dpp_z<DPP_SHL14>(pm_), cur[e]); }
                        else { z1 = dpp_z<DPP_SHR1>(cur[e]); z2 = dpp_z<DPP_SHR2>(cur[e]); }
                        const float y = fmaf(t0[e], z2, fmaf(t1[e], z1, fmaf(t2[e], cur[e], tb[e])));
                        o[e] = gelu_t(y) * acc[ai][1][m][n][e];
                    }
                    if (n == 0) { half[m].x = pk2(o[0], o[1]); half[m].y = pk2(o[2], o[3]); }
                    else { u32x4 w; w.x = half[m].x; w.y = half[m].y; w.z = pk2(o[0], o[1]); w.w = pk2(o[2], o[3]);
                        const int row = rbase + 16 * m;
                        if ((m > 0 || fr >= 2) && row < T) *(u32x4*)(gcol + (size_t)row * 64) = w; }
                }
            }
        }
    }
};

struct Frame {
    unsigned char* lds;
    int tid, lane, wave, G, bid;
    unsigned char* ws;
};

__device__ __forceinline__ void transpose_item(const float* W, int ldw, int c0, int nvalid, const float* gain, bf16* WT, int ldk, int r0, int nblk, float* scr, int item, int lane, int kmul = 1) {
    const int kb = item / nblk, nb = item % nblk, k0 = 64 * kb, n0 = 32 * nb;
    const int nn = lane & 31; const bool ok = (n0 + nn) < nvalid;
    const float* src = W + (size_t)(k0 + (lane >> 5)) * ldw + c0 + n0 + nn;
    float v[32];
#pragma unroll
    for (int i = 0; i < 32; ++i) v[i] = ok ? __builtin_nontemporal_load(src + (size_t)(2 * i) * ldw) : 0.f;
#pragma unroll
    for (int i = 0; i < 32; ++i) scr[(2 * i + (lane >> 5)) * 33 + nn] = v[i];
    asm volatile("s_waitcnt lgkmcnt(0)" ::: "memory");
    const int c = lane & 7;
    f32x4 g0 = {1.f, 1.f, 1.f, 1.f}, g1 = g0;
    if (gain) { g0 = *(const f32x4*)(gain + k0 + 8 * c); g1 = *(const f32x4*)(gain + k0 + 8 * c + 4); }
#pragma unroll
    for (int j = 0; j < 4; ++j) { const int n = (lane >> 3) + 8 * j; const float* s = scr + (8 * c) * 33 + n;
        u32x4 o; o.x = pk2(s[0 * 33] * g0[0], s[1 * 33] * g0[1]); o.y = pk2(s[2 * 33] * g0[2], s[3 * 33] * g0[3]); o.z = pk2(s[4 * 33] * g1[0], s[5 * 33] * g1[1]); o.w = pk2(s[6 * 33] * g1[2], s[7 * 33] * g1[3]);
        *(u32x4*)(WT + (size_t)(r0 + n0 + n) * ldk + (size_t)k0 * kmul + 8 * c) = o; }
    asm volatile("s_waitcnt lgkmcnt(0)" ::: "memory");
}
__device__ __forceinline__ void p0_prologue(const Frame& F, const Args& A) {
    float* scr = (float*)(F.lds + F.wave * 16384);
    const int gw = F.bid * NWAVES + F.wave, NGW = F.G * NWAVES;
    unsigned char* ws = F.ws;
    constexpr int I_IN1 = 32 * (2560 / 32), I_IN2 = 32 * (2048 / 32), I_IN3 = 32 * (256 / 32), I_IN4 = 32 * 128;
    constexpr int I_OUT = 32 * (2048 / 32), I_PA = 16 * (2048 / 32);
    constexpr int I_W1 = 64 * 4, I_W2 = 2 * 4;
    constexpr int NITEMS = I_IN1 + I_IN2 + I_IN3 + I_IN4 + I_OUT + 2 * I_PA + 2 * I_W1 + 2 * I_W2;
    for (int it = gw; it < NITEMS; it += NGW) {
        int r = it;
        if (r < I_IN1) { transpose_item(A.in[2], INW, 0, 2560, A.in[1], (bf16*)(ws + WS_WIN), 2048, 0, 2560 / 32, scr, r, F.lane); continue; } r -= I_IN1;
        if (r < I_IN2) { transpose_item(A.in[2], INW, 2584, 2048, A.in[1], (bf16*)(ws + WS_WIN), 2048, 2560, 2048 / 32, scr, r, F.lane); continue; } r -= I_IN2;
        if (r < I_IN3) { transpose_item(A.in[2], INW, 2560, 24, A.in[1], (bf16*)(ws + WS_WIN), 2048, 7936, 256 / 32, scr, r, F.lane); continue; } r -= I_IN3;
        if (r < I_IN4) { const int chunk = r >> 7, which = chunk & 1, k = chunk >> 1;
          transpose_item(A.in[2], INW, (which ? 6680 : 4632) + 128 * k, 128, A.in[1], (bf16*)(ws + WS_WIN), 2048, (k < 13 ? 18 + k : 19 + k) * 256 + 128 * which, 4, scr, r & 127, F.lane); continue; } r -= I_IN4;
        if (r < I_OUT) { transpose_item(A.in[15], 2048, 0, 2048, nullptr, (bf16*)(ws + WS_WOUT), 2048, 0, 2048 / 32, scr, r, F.lane); continue; } r -= I_OUT;
        if (r < I_PA) { transpose_item(A.in[13], 2048, 0, 2048, nullptr, (bf16*)(ws + WS_WPA), 2048, 0, 2048 / 32, scr, r, F.lane); continue; } r -= I_PA;
        if (r < I_PA) { transpose_item(A.in[14], 2048, 0, 2048, nullptr, (bf16*)(ws + WS_WPB), 2048, 0, 2048 / 32, scr, r, F.lane); continue; } r -= I_PA;
        if (r < I_W1) { transpose_item(A.in[4], 128, 0, 128, nullptr, (bf16*)(ws + WS_W1T), 4096, 0, 4, scr, r, F.lane); continue; } r -= I_W1;
        if (r < I_W1) { transpose_item(A.in[7], 128, 0, 128, nullptr, (bf16*)(ws + WS_W1T) + 128 * 4096, 4096, 0, 4, scr, r, F.lane); continue; } r -= I_W1;
        if (r < I_W2) { transpose_item(A.in[5], 128, 0, 128, nullptr, (bf16*)(ws + WS_W2T), 128, 0, 4, scr, r, F.lane); continue; } r -= I_W2;
        transpose_item(A.in[8], 128, 0, 128, nullptr, (bf16*)(ws + WS_W2T) + 128 * 128, 128, 0, 4, scr, r, F.lane);
    }
    for (int cidx = F.bid * NTHR + F.tid; cidx < DFF; cidx += F.G * NTHR) { const float* cw_ = A.in[18]; const float* cb_ = A.in[19];
        u32x2 w; w.x = pk2(cw_[cidx], cw_[DFF + cidx]); w.y = pk2(cw_[2 * DFF + cidx], cb_[cidx]); *(u32x2*)(ws + WS_CONVP + (size_t)cidx * 8) = w; }
    const float* x = A.in[0]; bf16* h = (bf16*)(ws + WS_H);
    for (int m0 = gw; m0 < T; m0 += 2 * NGW) {
        const int m1 = m0 + NGW; const bool has1 = m1 < T; const int m1c = has1 ? m1 : m0;
        const f32x4* xa = (const f32x4*)(x + (size_t)m0 * DM) + F.lane; const f32x4* xb = (const f32x4*)(x + (size_t)m1c * DM) + F.lane;
        f32x4 va[8], vb[8]; float sa = 0.f, sb = 0.f;
#pragma unroll
        for (int j = 0; j < 8; ++j) { va[j] = __builtin_nontemporal_load(xa + 64 * j); vb[j] = __builtin_nontemporal_load(xb + 64 * j); }
#pragma unroll
        for (int j = 0; j < 8; ++j) { sa += (va[j][0] * va[j][0] + va[j][1] * va[j][1]) + (va[j][2] * va[j][2] + va[j][3] * va[j][3]); sb += (vb[j][0] * vb[j][0] + vb[j][1] * vb[j][1]) + (vb[j][2] * vb[j][2] + vb[j][3] * vb[j][3]); }
        const float ra = rsqrtf(wave_sum(sa) * (1.0f / DM) + NORM_EPS), rb = rsqrtf(wave_sum(sb) * (1.0f / DM) + NORM_EPS);
        if (F.lane == 0) { float* ri = (float*)(ws + WS_RINV); ri[m0] = 1.0f / ra; if (has1) ri[m1] = 1.0f / rb; }
        u32x2* oa = (u32x2*)(h + (size_t)m0 * DM) + F.lane; u32x2* ob = (u32x2*)(h + (size_t)m1c * DM) + F.lane;
#pragma unroll
        for (int j = 0; j < 8; ++j) { u32x2 w; w.x = pk2(va[j][0] * ra, va[j][1] * ra); w.y = pk2(va[j][2] * ra, va[j][3] * ra); oa[64 * j] = w; }
        if (has1) {
#pragma unroll
            for (int j = 0; j < 8; ++j) { u32x2 w; w.x = pk2(vb[j][0] * rb, vb[j][1] * rb); w.y = pk2(vb[j][2] * rb, vb[j][3] * rb); ob[64 * j] = w; } }
    }
}
__device__ __forceinline__ void convert_wffn(const Frame& F, const Args& A, int slot, int nslots) {
    float* scr = (float*)(F.lds + F.wave * 16384);
    constexpr int I_FFN = 32 * (11008 / 32);
    for (int r = slot * NWAVES + F.wave; r < I_FFN; r += nslots * NWAVES) { const int n0 = 32 * (r % (11008 / 32)); const int csrc = ((n0 >> 7) & 1) * DFF + (n0 >> 8) * 128 + (n0 & 127);
        transpose_item(A.in[17], 2 * DFF, csrc - n0, 2 * DFF, A.in[16], (bf16*)(F.ws + WS_WFFN), 2048, 0, 11008 / 32, scr, r, F.lane); }
}
__device__ __forceinline__ void convert_wdown(const Frame& F, const Args& A, int slot, int nslots) {
    float* scr = (float*)(F.lds + F.wave * 16384);
    constexpr int I_DOWN = (DFF / 64) * (2048 / 32);
    for (int r = slot * NWAVES + F.wave; r < I_DOWN; r += nslots * NWAVES) transpose_item(A.in[20], 2048, 0, 2048, nullptr, (bf16*)(F.ws + WS_WDOWN), 64, 0, 2048 / 32, scr, r, F.lane, 2048);
}

namespace p2 {
#define PLAS __attribute__((address_space(3)))
typedef short bf16x8 __attribute__((ext_vector_type(8)));
typedef short s16x4 __attribute__((ext_vector_type(4)));
typedef float f32x16 __attribute__((ext_vector_type(16)));
__device__ __forceinline__ s16x4 vtr(const PLAS char* p) { return __builtin_bit_cast(s16x4, __builtin_amdgcn_ds_read_tr16_b64_v4i16((PLAS s16x4*)p)); }
__device__ __forceinline__ bf16x8 pack8(const float (&v)[8]) { u32x4 w; w.x = pk2(v[0], v[1]); w.y = pk2(v[2], v[3]); w.z = pk2(v[4], v[5]); w.w = pk2(v[6], v[7]); return __builtin_bit_cast(bf16x8, w); }
__device__ __forceinline__ void unpack8(const u32x4 w, float (&v)[8]) { v[0] = bflo(w.x); v[1] = bfhi(w.x); v[2] = bflo(w.y); v[3] = bfhi(w.y); v[4] = bflo(w.z); v[5] = bfhi(w.z); v[6] = bflo(w.w); v[7] = bfhi(w.w); }
constexpr int CP_STR = 132;
constexpr int CP_HB = 8 * 32 * CP_STR * 4;
__device__ __forceinline__ void compress_item(const Frame& F, const Args& A, int item) {
    PLAS char* L = (PLAS char*)F.lds; const int lane = F.lane, wave = F.wave, c = lane & 31, hf = lane >> 5;
    const int kvsel = item >> 5, g = (item >> 4) & 1, n0 = (item & 15) * 32;
    const bf16* Ab = (const bf16*)(F.ws + WS_KV) + (size_t)kvsel * T * 256 + (size_t)g * T * 128 + (size_t)(n0 + c) * 2048 + wave * 512 + 8 * hf;
    const float* peg = A.in[kvsel ? 6 : 3];
    PLAS float* pel = (PLAS float*)L;
    __syncthreads();
    for (int e = F.tid; e < 1024; e += NTHR) *(PLAS f32x4*)(pel + 4 * e) = *(const f32x4*)(peg + 4 * e);
    __syncthreads();
    const PLAS float* pe = pel + wave * 512 + 8 * hf;
    const bf16* Bb = (const bf16*)(F.ws + WS_W1T) + (size_t)kvsel * 128 * 4096 + (size_t)c * 4096 + wave * 512 + 8 * hf;
    f32x16 acc[4];
#pragma unroll
    for (int cb = 0; cb < 4; ++cb)
#pragma unroll
        for (int r = 0; r < 16; ++r) acc[cb][r] = 0.f;
#pragma unroll 8
    for (int ks = 0; ks < 32; ++ks) {
        const u32x4 aw = *(const u32x4*)(Ab + 16 * ks); const f32x4 p0 = *(const PLAS f32x4*)(pe + 16 * ks), p1 = *(const PLAS f32x4*)(pe + 16 * ks + 4);
        float av[8]; unpack8(aw, av);
        av[0] += p0[0]; av[1] += p0[1]; av[2] += p0[2]; av[3] += p0[3]; av[4] += p1[0]; av[5] += p1[1]; av[6] += p1[2]; av[7] += p1[3];
        const bf16x8 af = pack8(av);
#pragma unroll
        for (int cb = 0; cb < 4; ++cb) { const bf16x8 bfr = *(const bf16x8*)(Bb + (size_t)cb * 32 * 4096 + 16 * ks); acc[cb] = __builtin_amdgcn_mfma_f32_32x32x16_bf16(af, bfr, acc[cb], 0, 0, 0); }
    }
    __syncthreads();
    PLAS float* part = (PLAS float*)L + wave * 32 * CP_STR;
#pragma unroll
    for (int cb = 0; cb < 4; ++cb)
#pragma unroll
        for (int r = 0; r < 16; ++r) part[((r & 3) + 8 * (r >> 2) + 4 * hf) * CP_STR + cb * 32 + c] = acc[cb][r];
    __syncthreads();
    PLAS char* hb = L + CP_HB;
    for (int e = F.tid; e < 32 * 128; e += NTHR) { const int row = e >> 7, col = e & 127; float sum = 0.f;
#pragma unroll
        for (int w = 0; w < 8; ++w) sum += ((PLAS float*)L)[(w * 32 + row) * CP_STR + col];
        *(PLAS unsigned short*)(hb + row * 272 + col * 2) = (unsigned short)f2bf(gelu_t(sum)); }
    __syncthreads();
    if (wave < 4) {
        const bf16* B2 = (const bf16*)(F.ws + WS_W2T) + (size_t)kvsel * 128 * 128 + (size_t)(wave * 32 + c) * 128 + 8 * hf;
        f32x16 o;
#pragma unroll
        for (int r = 0; r < 16; ++r) o[r] = 0.f;
#pragma unroll
        for (int ks = 0; ks < 8; ++ks) { const bf16x8 af = *(const PLAS bf16x8*)(hb + c * 272 + (16 * ks + 8 * hf) * 2); const bf16x8 bfr = *(const bf16x8*)(B2 + 16 * ks);
            o = __builtin_amdgcn_mfma_f32_32x32x16_bf16(af, bfr, o, 0, 0, 0); }
        bf16* dst = (bf16*)(F.ws + WS_KC) + (size_t)kvsel * 2 * 512 * 128 + (size_t)g * 512 * 128;
#pragma unroll
        for (int r = 0; r < 16; ++r) { const int n = n0 + (r & 3) + 8 * (r >> 2) + 4 * hf; dst[(size_t)n * 128 + wave * 32 + c] = (bf16)(n < 511 ? f2bf(o[r]) : 0u); }
    }
    __syncthreads();
}
constexpr int SG_STR = 320;
__device__ __forceinline__ void sgu_item(const Frame& F, const Args& A, int item) {
    PLAS char* L = (PLAS char*)F.lds; const int tid = F.tid, lane = F.lane, wave = F.wave, c = lane & 31, hf = lane >> 5;
    const int ch = item >> 3, g = item & 7;
    const bf16* gu = (const bf16*)(F.ws + WS_U); const bf16* gv = (const bf16*)(F.ws + WS_V); bf16* yb = (bf16*)(F.ws + WS_YB);
    const float* vs = (const float*)(F.ws + WS_VSTAT);
    const float* ln_g = A.in[9]; const float* ln_b = A.in[10]; const float* sw = A.in[11] + (size_t)g * 128 * 128; const float* sb = A.in[12] + g * 128;
    PLAS float* st = (PLAS float*)(L + 128 * SG_STR);
    const int tb = wave >> 1, cb0 = (wave & 1) * 2, t = 32 * tb + c;
    f32x4 sp[8];
    { const f32x4* p = (const f32x4*)(vs + (size_t)(ch * 128 + (tid & 127)) * 32);
#pragma unroll
      for (int i = 0; i < 8; ++i) sp[i] = p[i]; }
    u32x4 vw[4]; f32x4 lg0[4], lg1[4], lb0[4], lb1[4];
#pragma unroll
    for (int i = 0; i < 4; ++i) { const int id = tid + NTHR * i, s = id >> 4, dc = id & 15;
        vw[i] = __builtin_nontemporal_load((const u32x4*)(gv + (size_t)(ch * 128 + s) * SGW + g * 128 + dc * 8));
        lg0[i] = *(const f32x4*)(ln_g + g * 128 + dc * 8); lg1[i] = *(const f32x4*)(ln_g + g * 128 + dc * 8 + 4); lb0[i] = *(const f32x4*)(ln_b + g * 128 + dc * 8); lb1[i] = *(const f32x4*)(ln_b + g * 128 + dc * 8 + 4); }
    f32x4 wv[8][2];
#pragma unroll
    for (int ks = 0; ks < 8; ++ks) if (ks < 2 * tb + 2) { wv[ks][0] = *(const f32x4*)(sw + (size_t)t * 128 + 16 * ks + 8 * hf); wv[ks][1] = *(const f32x4*)(sw + (size_t)t * 128 + 16 * ks + 8 * hf + 4); }
    unsigned short guv[2][16]; float sbv[16];
#pragma unroll
    for (int r = 0; r < 16; ++r) { const int tt = 32 * tb + (r & 3) + 8 * (r >> 2) + 4 * hf; sbv[r] = sb[tt];
#pragma unroll
        for (int j = 0; j < 2; ++j) guv[j][r] = __builtin_nontemporal_load(gu + (size_t)(ch * 128 + tt) * SGW + g * 128 + (cb0 + j) * 32 + c); }
    if (tid < 128) { float s1 = 0.f, s2 = 0.f;
#pragma unroll
        for (int i = 0; i < 8; ++i) { s1 += sp[i][0] + sp[i][2]; s2 += sp[i][1] + sp[i][3]; }
        const float mean = s1 * (1.0f / SGW), var = fmaxf(s2 * (1.0f / SGW) - mean * mean, 0.f);
        st[2 * tid] = mean; st[2 * tid + 1] = rsqrtf(var + LN_EPS); }
    __syncthreads();
#pragma unroll
    for (int i = 0; i < 4; ++i) { const int id = tid + NTHR * i, s = id >> 4, dc = id & 15;
        float v[8]; unpack8(vw[i], v);
        const float mean = st[2 * s], rstd = st[2 * s + 1];
#pragma unroll
        for (int e = 0; e < 4; ++e) { v[e] = (v[e] - mean) * rstd * lg0[i][e] + lb0[i][e]; v[4 + e] = (v[4 + e] - mean) * rstd * lg1[i][e] + lb1[i][e]; }
        *(PLAS bf16x8*)(L + s * SG_STR + dc * 16) = pack8(v); }
    __syncthreads();
    f32x16 acc[2];
#pragma unroll
    for (int j = 0; j < 2; ++j)
#pragma unroll
        for (int r = 0; r < 16; ++r) acc[j][r] = 0.f;
    const PLAS char* vp = L + (8 * hf + ((lane & 15) >> 2)) * SG_STR + (16 * ((lane >> 4) & 1) + 4 * (lane & 3)) * 2;
#pragma unroll
    for (int ks = 0; ks < 8; ++ks) if (ks < 2 * tb + 2) {
        float av[8]; const int s0 = 16 * ks + 8 * hf;
#pragma unroll
        for (int e = 0; e < 4; ++e) { av[e] = (s0 + e <= t) ? wv[ks][0][e] : 0.f; av[4 + e] = (s0 + 4 + e <= t) ? wv[ks][1][e] : 0.f; }
        const bf16x8 af = pack8(av);
#pragma unroll
        for (int j = 0; j < 2; ++j) { const s16x4 lo = vtr(vp + 16 * ks * SG_STR + (cb0 + j) * 64), hi = vtr(vp + (16 * ks + 4) * SG_STR + (cb0 + j) * 64);
            const bf16x8 bfr = (bf16x8){lo[0], lo[1], lo[2], lo[3], hi[0], hi[1], hi[2], hi[3]};
            acc[j] = __builtin_amdgcn_mfma_f32_32x32x16_bf16(af, bfr, acc[j], 0, 0, 0); }
    }
#pragma unroll
    for (int j = 0; j < 2; ++j)
#pragma unroll
        for (int r = 0; r < 16; ++r) { const int tt = 32 * tb + (r & 3) + 8 * (r >> 2) + 4 * hf;
            yb[(size_t)(ch * 128 + tt) * YLD + g * 128 + (cb0 + j) * 32 + c] = (bf16)f2bf((acc[j][r] + sbv[r]) * bf2f(guv[j][r])); }
    __syncthreads();
}
}
constexpr int SGU_EARLY = 288;
__host__ __device__ __forceinline__ void sgu_filler(int tq, int g, int& first, int& cnt) {
    int pre;
    if (tq < 10) { pre = 4 * tq; cnt = 4; } else if (tq < 21) { pre = 40 + 3 * (tq - 10); cnt = 3; } else if (tq < 32) { pre = 73 + 2 * (tq - 21); cnt = 2; } else if (tq < 49) { pre = 95 + (tq - 32); cnt = 1; } else { pre = 112; cnt = 0; }
    first = SGU_EARLY + 112 * g + pre;
}
__device__ __forceinline__ void p2_phase(const Frame& F, const Args& A, int b0) {
    const int nb = F.G - b0, b = F.bid - b0;
    if (b < 0) return;
    int it, step, end;
    if (nb >= 128) {
        if (b < 64) { p2::compress_item(F, A, b); it = 0; step = 1; end = 0; }
        else { it = b - 64; step = nb - 64; end = SGU_EARLY; }
    } else {
        for (int c = b; c < 64; c += nb) p2::compress_item(F, A, c);
        it = b; step = nb; end = SGU_EARLY;
    }
    for (; it < end; it += step) p2::sgu_item(F, A, it);
}

namespace nsa {
#define NLAS __attribute__((address_space(3)))
typedef short bf16x8 __attribute__((ext_vector_type(8)));
typedef short s16x4 __attribute__((ext_vector_type(4)));
typedef float f32x16 __attribute__((ext_vector_type(16)));
constexpr int IMPS = 132, KIMG = 16384, STG = 32768;
constexpr int L_IMP = 3 * STG, L_SELM = L_IMP + 64 * IMPS * 4, L_UM = L_SELM + 1024, L_TL = L_UM + 16, L_END = L_TL + 132 * 4;
static_assert(L_END <= LDS_BYTES - 16, "nsa LDS map");
constexpr float NEG = -1.0e30f, M_INIT = -1.0e20f, RESC_THR = 5.0f;

__device__ __forceinline__ void dma_k(const char* kt, int ks, NLAS char* kdst, int wave, int lane) {
    const int r0 = 8 * wave + (lane >> 4), p = lane & 15;
    const char* src = kt + (size_t)r0 * ks + ((p ^ (r0 & 15)) << 4);
    __builtin_amdgcn_global_load_lds((const unsigned*)src, (NLAS unsigned*)(kdst + wave * 2048), 16, 0, 0);
    const char* src1 = kt + (size_t)(r0 + 4) * ks + ((p ^ ((r0 + 4) & 15)) << 4);
    __builtin_amdgcn_global_load_lds((const unsigned*)src1, (NLAS unsigned*)(kdst + wave * 2048 + 1024), 16, 0, 0);
}
__device__ __forceinline__ void dma_v(const char* vt, int vs, NLAS char* vdst, int wave, int lane) {
    const int db = wave >> 1, pr = 2 * (wave & 1);
    const char* src = vt + (size_t)(16 * pr + (lane >> 2)) * vs + db * 64 + (lane & 3) * 16;
    __builtin_amdgcn_global_load_lds((const unsigned*)src, (NLAS unsigned*)(vdst + db * 4096 + pr * 1024), 16, 0, 0);
    __builtin_amdgcn_global_load_lds((const unsigned*)(src + (size_t)16 * vs), (NLAS unsigned*)(vdst + db * 4096 + pr * 1024 + 1024), 16, 0, 0);
}
#define NSA_WAIT(n) asm volatile("s_waitcnt vmcnt(" #n ") lgkmcnt(0)" ::: "memory")
#define NSA_BAR() do { __builtin_amdgcn_s_barrier(); asm volatile("" ::: "memory"); } while (0)

__device__ __forceinline__ float ror8(float v) { return __uint_as_float((unsigned)__builtin_amdgcn_update_dpp(0, (int)__float_as_uint(v), 0x128  , 0xF, 0xF, false)); }
__device__ __forceinline__ float xor16(float v) {
    auto rr = __builtin_amdgcn_permlane16_swap(__float_as_uint(v), __float_as_uint(v), false, false);
    return (threadIdx.x & 16) ? __uint_as_float(rr[0]) : __uint_as_float(rr[1]);
}
__device__ __forceinline__ float swap_other(float v) {
    auto rr = __builtin_amdgcn_permlane32_swap(__float_as_uint(v), __float_as_uint(v), false, false);
    const unsigned lo = rr[0], hi = rr[1];
    return (threadIdx.x & 32) ? __uint_as_float(lo) : __uint_as_float(hi);
}
#define KCONST(kb, r) (32 * (kb) + ((r) & 3) + 8 * ((r) >> 2))
__device__ __forceinline__ void qk_tile(f32x16 (&S)[2], const NLAS char* kbuf, const bf16x8 (&qf)[8], float base2, float sl2p, int lane) {
    const unsigned ka0 = (unsigned)(size_t)kbuf + (lane & 31) * 256 + (((lane >> 5) ^ (lane & 15)) << 4);
#define QK_LD(d0, d1, ks) do { const NLAS char* kp_ = (const NLAS char*)(size_t)(ka0 ^ ((ks) << 5)); d0 = *(const NLAS bf16x8*)kp_; d1 = *(const NLAS bf16x8*)(kp_ + 8192); } while (0)
#define QK_MM(s0, s1, ks) do { S[0] = __builtin_amdgcn_mfma_f32_32x32x16_bf16(s0, qf[ks], S[0], 0, 0, 0); S[1] = __builtin_amdgcn_mfma_f32_32x32x16_bf16(s1, qf[ks], S[1], 0, 0, 0); } while (0)
#define SB() __builtin_amdgcn_sched_barrier(0)
    bf16x8 a0, a1, b0, b1;
    QK_LD(a0, a1, 0);
#pragma unroll
    for (int kb = 0; kb < 2; ++kb)
#pragma unroll
        for (int r = 0; r < 16; ++r) S[kb][r] = fmaf(sl2p, (float)KCONST(kb, r), base2);
    SB();
    QK_LD(b0, b1, 1); SB(); QK_MM(a0, a1, 0); SB();
    QK_LD(a0, a1, 2); SB(); QK_MM(b0, b1, 1); SB();
    QK_LD(b0, b1, 3); SB(); QK_MM(a0, a1, 2); SB();
    QK_LD(a0, a1, 4); SB(); QK_MM(b0, b1, 3); SB();
    QK_LD(b0, b1, 5); SB(); QK_MM(a0, a1, 4); SB();
    QK_LD(a0, a1, 6); SB(); QK_MM(b0, b1, 5); SB();
    QK_LD(b0, b1, 7); SB(); QK_MM(a0, a1, 6); SB();
    QK_MM(b0, b1, 7);
#undef QK_LD
#undef QK_MM
}
__device__ __forceinline__ void mask_tile(f32x16 (&S)[2], int dbase, int pscale, unsigned dmax) {
#pragma unroll
    for (int kb = 0; kb < 2; ++kb)
#pragma unroll
        for (int r = 0; r < 16; ++r) { const unsigned d = (unsigned)(dbase - pscale * KCONST(kb, r)); S[kb][r] = d < dmax ? S[kb][r] : NEG; }
}
__device__ __forceinline__ float tile_max(const f32x16 (&S)[2]) {
    float a = fmaxf(S[0][0], S[1][0]);
#pragma unroll
    for (int r = 1; r < 16; ++r) a = fmaxf(fmaxf(a, S[0][r]), S[1][r]);
    return fmaxf(a, swap_other(a));
}
__device__ __forceinline__ s16x4 vtr(const NLAS char* p) { return __builtin_bit_cast(s16x4, __builtin_amdgcn_ds_read_tr16_b64_v4i16((NLAS s16x4*)p)); }
__device__ __forceinline__ void pack_p(bf16x8 (&pf)[4], const f32x16 (&S)[2]) {
#pragma unroll
    for (int kb = 0; kb < 2; ++kb)
#pragma unroll
        for (int s = 0; s < 2; ++s) { u32x4 pw; pw.x = pk2(S[kb][8 * s + 0], S[kb][8 * s + 1]); pw.y = pk2(S[kb][8 * s + 2], S[kb][8 * s + 3]); pw.z = pk2(S[kb][8 * s + 4], S[kb][8 * s + 5]); pw.w = pk2(S[kb][8 * s + 6], S[kb][8 * s + 7]);
            pf[kb * 2 + s] = __builtin_bit_cast(bf16x8, pw); }
}
__device__ __forceinline__ void pv_tile(f32x16 (&O)[4], const bf16x8 (&pf)[4], const NLAS char* vbuf, int lane) {
    const NLAS char* vp = vbuf + (4 * (lane >> 5) + ((lane & 15) >> 2)) * 64 + 32 * ((lane >> 4) & 1) + 8 * (lane & 3);
#define PV_RD(x, off) asm volatile("ds_read_b64_tr_b16 %0, %1 offset:%2" : "=v"(x) : "v"(va), "n"(off))
#define PV_LD(l0, h0, l1, h1, g) do { PV_RD(l0, ((g) >> 1) * 1024 + (2 * ((g) & 1)) * 4096); PV_RD(h0, ((g) >> 1) * 1024 + 512 + (2 * ((g) & 1)) * 4096); \
                                      PV_RD(l1, ((g) >> 1) * 1024 + (2 * ((g) & 1) + 1) * 4096); PV_RD(h1, ((g) >> 1) * 1024 + 512 + (2 * ((g) & 1) + 1) * 4096); } while (0)
#define PV_WT(n, l0, h0, l1, h1) asm volatile("s_waitcnt lgkmcnt(" #n ")" : "+v"(l0), "+v"(h0), "+v"(l1), "+v"(h1))
#define PV_MM(l0, h0, l1, h1, g) do { O[2 * ((g) & 1)] = __builtin_amdgcn_mfma_f32_32x32x16_bf16((bf16x8){l0[0], l0[1], l0[2], l0[3], h0[0], h0[1], h0[2], h0[3]}, pf[(g) >> 1], O[2 * ((g) & 1)], 0, 0, 0); \
                                      O[2 * ((g) & 1) + 1] = __builtin_amdgcn_mfma_f32_32x32x16_bf16((bf16x8){l1[0], l1[1], l1[2], l1[3], h1[0], h1[1], h1[2], h1[3]}, pf[(g) >> 1], O[2 * ((g) & 1) + 1], 0, 0, 0); } while (0)
    const unsigned va = (unsigned)(size_t)vp;
    s16x4 la0, ha0, la1, ha1, lb0, hb0, lb1, hb1;
    PV_LD(la0, ha0, la1, ha1, 0); SB();
    PV_LD(lb0, hb0, lb1, hb1, 1); SB(); PV_WT(4, la0, ha0, la1, ha1); PV_MM(la0, ha0, la1, ha1, 0); SB();
    PV_LD(la0, ha0, la1, ha1, 2); SB(); PV_WT(4, lb0, hb0, lb1, hb1); PV_MM(lb0, hb0, lb1, hb1, 1); SB();
    PV_LD(lb0, hb0, lb1, hb1, 3); SB(); PV_WT(4, la0, ha0, la1, ha1); PV_MM(la0, ha0, la1, ha1, 2); SB();
    PV_LD(la0, ha0, la1, ha1, 4); SB(); PV_WT(4, lb0, hb0, lb1, hb1); PV_MM(lb0, hb0, lb1, hb1, 3); SB();
    PV_LD(lb0, hb0, lb1, hb1, 5); SB(); PV_WT(4, la0, ha0, la1, ha1); PV_MM(la0, ha0, la1, ha1, 4); SB();
    PV_LD(la0, ha0, la1, ha1, 6); SB(); PV_WT(4, lb0, hb0, lb1, hb1); PV_MM(lb0, hb0, lb1, hb1, 5); SB();
    PV_LD(lb0, hb0, lb1, hb1, 7); SB(); PV_WT(4, la0, ha0, la1, ha1); PV_MM(la0, ha0, la1, ha1, 6); SB();
    PV_WT(0, lb0, hb0, lb1, hb1); PV_MM(lb0, hb0, lb1, hb1, 7);
#undef PV_RD
#undef PV_WT
#undef PV_LD
#undef PV_MM
#undef SB
}
__device__ __forceinline__ void pv_sm_tile(f32x16 (&O)[4], bf16x8 (&pf)[4], const NLAS char* vbuf, int lane, f32x16 (&S)[2], float& ls) {
    const NLAS char* vp = vbuf + (4 * (lane >> 5) + ((lane & 15) >> 2)) * 64 + 32 * ((lane >> 4) & 1) + 8 * (lane & 3);
#define SB() __builtin_amdgcn_sched_barrier(0)
#define PV_RD(x, off) asm volatile("ds_read_b64_tr_b16 %0, %1 offset:%2" : "=v"(x) : "v"(va), "n"(off))
#define PV_LD(l0, h0, l1, h1, g) do { PV_RD(l0, ((g) >> 1) * 1024 + (2 * ((g) & 1)) * 4096); PV_RD(h0, ((g) >> 1) * 1024 + 512 + (2 * ((g) & 1)) * 4096); \
                                      PV_RD(l1, ((g) >> 1) * 1024 + (2 * ((g) & 1) + 1) * 4096); PV_RD(h1, ((g) >> 1) * 1024 + 512 + (2 * ((g) & 1) + 1) * 4096); } while (0)
#define PV_WT(n, l0, h0, l1, h1) asm volatile("s_waitcnt lgkmcnt(" #n ")" : "+v"(l0), "+v"(h0), "+v"(l1), "+v"(h1))
#define PV_M0(l0, h0, g) O[2 * ((g) & 1)] = __builtin_amdgcn_mfma_f32_32x32x16_bf16((bf16x8){l0[0], l0[1], l0[2], l0[3], h0[0], h0[1], h0[2], h0[3]}, pf[(g) >> 1], O[2 * ((g) & 1)], 0, 0, 0)
#define PV_M1(l1, h1, g) O[2 * ((g) & 1) + 1] = __builtin_amdgcn_mfma_f32_32x32x16_bf16((bf16x8){l1[0], l1[1], l1[2], l1[3], h1[0], h1[1], h1[2], h1[3]}, pf[(g) >> 1], O[2 * ((g) & 1) + 1], 0, 0, 0)
#define SM_E2(c) do { float s0 = S[(c) >> 3][2 * ((c) & 7)], s1 = S[(c) >> 3][2 * ((c) & 7) + 1]; asm volatile("" : "+v"(s0), "+v"(s1)); \
                      float p0 = __builtin_amdgcn_exp2f(s0), p1 = __builtin_amdgcn_exp2f(s1); ls += p0; ls += p1; asm volatile("" : "+v"(p0), "+v"(p1), "+v"(ls)); \
                      S[(c) >> 3][2 * ((c) & 7)] = p0; S[(c) >> 3][2 * ((c) & 7) + 1] = p1; } while (0)
#define SM_PKH(k, h) do { u32x2 pw; pw.x = pk2(S[(k) >> 1][8 * ((k) & 1) + 4 * (h) + 0], S[(k) >> 1][8 * ((k) & 1) + 4 * (h) + 1]); pw.y = pk2(S[(k) >> 1][8 * ((k) & 1) + 4 * (h) + 2], S[(k) >> 1][8 * ((k) & 1) + 4 * (h) + 3]); \
                            asm volatile("" : "+v"(pw.x), "+v"(pw.y)); u32x4 w_ = __builtin_bit_cast(u32x4, pf[k]); w_[2 * (h)] = pw.x; w_[2 * (h) + 1] = pw.y; pf[k] = __builtin_bit_cast(bf16x8, w_); } while (0)
    const unsigned va = (unsigned)(size_t)vp;
    s16x4 la0, ha0, la1, ha1, lb0, hb0, lb1, hb1;
    PV_LD(la0, ha0, la1, ha1, 0); SB();
    PV_LD(lb0, hb0, lb1, hb1, 1); SB(); PV_WT(4, la0, ha0, la1, ha1); PV_M0(la0, ha0, 0); SB(); SM_E2(0); SB(); PV_M1(la1, ha1, 0); SB(); SM_E2(1); SB();
    PV_LD(la0, ha0, la1, ha1, 2); SB(); PV_WT(4, lb0, hb0, lb1, hb1); PV_M0(lb0, hb0, 1); SB(); SM_E2(2); SB(); PV_M1(lb1, hb1, 1); SB(); SM_E2(3); SB();
    PV_LD(lb0, hb0, lb1, hb1, 3); SB(); PV_WT(4, la0, ha0, la1, ha1); PV_M0(la0, ha0, 2); SB(); SM_E2(4); SM_PKH(0, 0); SB(); PV_M1(la1, ha1, 2); SB(); SM_E2(5); SM_PKH(0, 1); SB();
    PV_LD(la0, ha0, la1, ha1, 4); SB(); PV_WT(4, lb0, hb0, lb1, hb1); PV_M0(lb0, hb0, 3); SB(); SM_E2(6); SB(); PV_M1(lb1, hb1, 3); SB(); SM_E2(7); SB();
    PV_LD(lb0, hb0, lb1, hb1, 5); SB(); PV_WT(4, la0, ha0, la1, ha1); PV_M0(la0, ha0, 4); SB(); SM_E2(8); SM_PKH(1, 0); SB(); PV_M1(la1, ha1, 4); SB(); SM_E2(9); SM_PKH(1, 1); SB();
    PV_LD(la0, ha0, la1, ha1, 6); SB(); PV_WT(4, lb0, hb0, lb1, hb1); PV_M0(lb0, hb0, 5); SB(); SM_E2(10); SB(); PV_M1(lb1, hb1, 5); SB(); SM_E2(11); SB();
    PV_LD(lb0, hb0, lb1, hb1, 7); SB(); PV_WT(4, la0, ha0, la1, ha1); PV_M0(la0, ha0, 6); SB(); SM_E2(12); SM_PKH(2, 0); SB(); PV_M1(la1, ha1, 6); SB(); SM_E2(13); SM_PKH(2, 1); SB();
    PV_WT(0, lb0, hb0, lb1, hb1); PV_M0(lb0, hb0, 7); SB(); SM_E2(14); SB(); PV_M1(lb1, hb1, 7); SB(); SM_E2(15); SB();
    SM_PKH(3, 0); SM_PKH(3, 1);
#undef PV_RD
#undef PV_LD
#undef PV_WT
#undef PV_M0
#undef PV_M1
#undef SM_E2
#undef SM_PKH
#undef SB
}
__device__ __forceinline__ void y_store(float* yp, const f32x16 (&O)[4], float f) {
#pragma unroll
    for (int db = 0; db < 4; ++db)
#pragma unroll
        for (int i = 0; i < 4; ++i) { u32x2 w; w.x = pk2(O[db][4 * i] * f, O[db][4 * i + 1] * f); w.y = pk2(O[db][4 * i + 2] * f, O[db][4 * i + 3] * f); *(u32x2*)(yp + (4 * db + i) * 128) = w; }
}

#define NSA_WAITN(n) do { const int _n = (n); if (_n >= 4) NSA_WAIT(4); else if (_n >= 2) NSA_WAIT(2); else NSA_WAIT(0); } while (0)
template <bool WIN> __device__ __forceinline__ void online_branch(const Frame& F, int tid, NLAS char* L, const bf16x8 (&qf)[8], f32x16 (&O)[4], float& l_out,
        const char* kg, const char* vg, const NLAS int* tl, int nt, int t, float sl2, int cur, const NLAS unsigned* selq) {
    const int lane = tid & 63, hf = lane >> 5, wave = F.wave;
    float m = 0.f, l = 0.f;
#pragma unroll
    for (int db = 0; db < 4; ++db)
#pragma unroll
        for (int r = 0; r < 16; ++r) O[db][r] = 0.f;
#define NSA_BEHIND(i) (2 * (((i) + 1 < nt ? 1 : 0) + ((i) < nt ? 1 : 0)))
    { const int j0 = tl[0]; dma_k(kg + (size_t)j0 * 64 * 512, 512, L, wave, lane);
      if (nt > 1) { const int j1 = tl[1]; dma_k(kg + (size_t)j1 * 64 * 512, 512, L + STG, wave, lane); }
      dma_v(vg + (size_t)j0 * 64 * 512, 512, L + KIMG, wave, lane); }
    int s_i = 0, s_im1 = 2 * STG;
    bf16x8 pf[4]; f32x16 S[2];
#define NSA_SCORES(i, alpha) do { \
        const int j = tl[i]; \
        bool colsel = true; \
        if (!WIN) { const unsigned w = selq[j >> 5]; colsel = (w >> (j & 31)) & 1u; } \
        const int dbase = t - 64 * j - 4 * hf; \
        const float base2 = colsel ? -sl2 * (float)dbase - m : NEG;     \
        qk_tile(S, L + s_i, qf, base2, sl2, lane); \
        const bool need_mask = WIN ? (j == cur || j == cur - 8) : (j == cur); \
        if (__builtin_amdgcn_readfirstlane((int)need_mask)) { asm volatile("" : "+v"(S[0]), "+v"(S[1])); mask_tile(S, dbase, 1, WIN ? 512u : 0x7fffffffu); }     \
        const float mx = tile_max(S); \
          \
        if ((i) == 0 || __any(mx > RESC_THR)) { const float dl = (i) == 0 ? (mx > -1.0e29f ? mx : 0.f) : fmaxf(mx, 0.f);     \
            alpha = (i) == 0 ? 1.0f : __builtin_amdgcn_exp2f(-dl); l *= alpha; m += dl; \
            _Pragma("unroll") for (int kb2 = 0; kb2 < 2; ++kb2) _Pragma("unroll") for (int r = 0; r < 16; ++r) S[kb2][r] -= dl; } \
    } while (0)
#define NSA_TOP(i) do { NSA_WAITN(NSA_BEHIND(i)); NSA_BAR(); \
        if ((i) + 2 < nt) { const int j2 = tl[(i) + 2]; dma_k(kg + (size_t)j2 * 64 * 512, 512, L + s_im1, wave, lane); }            \
        if ((i) + 1 < nt) { const int j1 = tl[(i) + 1]; dma_v(vg + (size_t)j1 * 64 * 512, 512, L + (s_i == 2 * STG ? 0 : s_i + STG) + KIMG, wave, lane); } } while (0)
#define NSA_ADV() do { const int s_n = s_i == 2 * STG ? 0 : s_i + STG; s_im1 = s_i; s_i = s_n; } while (0)
    {
        NSA_TOP(0);
        float alpha = 1.0f; NSA_SCORES(0, alpha);
        float ls = 0.f;
#pragma unroll
        for (int kb2 = 0; kb2 < 2; ++kb2)
#pragma unroll
            for (int r = 0; r < 16; ++r) { const float p = __builtin_amdgcn_exp2f(S[kb2][r]); S[kb2][r] = p; ls += p; }
        pack_p(pf, S); l += ls;
        NSA_ADV();
    }
    for (int i = 1; i < nt; ++i) {
        NSA_TOP(i);
        float alpha = 1.0f; NSA_SCORES(i, alpha);
        float ls = 0.f;
        pv_sm_tile(O, pf, L + s_im1 + KIMG, lane, S, ls);
        l += ls;
        if (__any(alpha != 1.0f)) {
#pragma unroll
            for (int db = 0; db < 4; ++db)
#pragma unroll
                for (int r = 0; r < 16; ++r) O[db][r] *= alpha; }
        NSA_ADV();
    }
    { NSA_TOP(nt); pv_tile(O, pf, L + s_im1 + KIMG, lane); }
#undef NSA_SCORES
#undef NSA_TOP
#undef NSA_ADV
    NSA_WAIT(0); NSA_BAR();
#undef NSA_BEHIND
    l_out = l + swap_other(l);
}
}

__device__ __forceinline__ void p3_attn(const Frame& F, const Args& A) {
    using namespace nsa;
    NLAS char* L = (NLAS char*)F.lds;
    const int wave = F.wave;
    const bf16* qb = (const bf16*)(F.ws + WS_Q); const char* kvb = (const char*)(F.ws + WS_KV);
    const char* kcb = (const char*)(F.ws + WS_KC); const float* ng = (const float*)(F.ws + WS_NSAG); bf16* ya = (bf16*)(F.ws + WS_YA);
    float* y32a = A.out; float* y32b = (float*)(F.ws + WS_WIN);
    NLAS float* imp = (NLAS float*)(L + L_IMP); NLAS unsigned* selm = (NLAS unsigned*)(L + L_SELM); NLAS unsigned* um = (NLAS unsigned*)(L + L_UM); NLAS int* tl = (NLAS int*)(L + L_TL);
    const int vcu = (F.G % 8 == 0) ? (F.bid % 8) * (F.G / 8) + F.bid / 8 : F.bid;
    for (int item = vcu; item < 256; item += F.G) {
        int tid = F.tid; asm volatile("" : "+v"(tid));
        const int lane = tid & 63, c = lane & 31, hf = lane >> 5, qi = c & 7, hh = c >> 3;
        const int tq = 127 - (item >> 1), g = item & 1, t0 = 64 * tq, cur = tq;
        const int t = t0 + 8 * wave + qi, head = 4 * g + hh;
        const float sl2 = exp2f(-(float)(head + 1)) * LOG2E;
        bf16x8 qf[8];
#pragma unroll
        for (int ks = 0; ks < 8; ++ks) qf[ks] = *(const bf16x8*)(qb + (size_t)t * QW + head * 128 + 16 * ks + 8 * hf);
        const float* gp = ng + (size_t)t * 24 + head * 3;
        const size_t yprv = ((size_t)item * 8 + wave) * 2048 + lane * 2;
        asm volatile("s_waitcnt vmcnt(0)" ::: "memory");
        __syncthreads();
        for (int e = tid; e < 64 * IMPS; e += NTHR) imp[e] = 0.f;
        if (tid < 4) um[tid] = 0u;
        const int nvmax = ((t0 + 63 - 31) >> 4) + 1, ntc = (nvmax + 63) >> 6;
        const char* kc = kcb + (size_t)g * 512 * 256; const char* vc = kcb + (size_t)2 * 512 * 256 + (size_t)g * 512 * 256;
        float m = M_INIT, l = 0.f;
        for (int rp = 0; rp < (ATT_DBL == 1 ? 2 : 1); ++rp) {
        m = M_INIT; l = 0.f;
        dma_k(kc, 256, L, wave, lane); if (ntc > 1) dma_k(kc + (size_t)64 * 256, 256, L + STG, wave, lane);
        int s_cur = 0, s_nxt2 = 2 * STG;
        for (int i = 0; i < ntc; ++i) {
            if (i + 1 < ntc) NSA_WAIT(2); else NSA_WAIT(0);
            NSA_BAR();
            if (i + 2 < ntc) dma_k(kc + (size_t)(i + 2) * 64 * 256, 256, L + s_nxt2, wave, lane);
            const int nb = 64 * i; const int dbase = t - 31 - 16 * (nb + 4 * hf);
            f32x16 S[2];
            qk_tile(S, L + s_cur, qf, -sl2 * (float)dbase, sl2 * 16.f, lane);
            if (16 * (nb + 63) + 31 > t0) { asm volatile("" : "+v"(S[0]), "+v"(S[1])); mask_tile(S, dbase, 16, 0x7fffffffu); }
            const float mnew = fmaxf(m, tile_max(S));
            l *= __builtin_amdgcn_exp2f(m - mnew); m = mnew;
            float ls = 0.f;
#pragma unroll
            for (int kb2 = 0; kb2 < 2; ++kb2)
#pragma unroll
                for (int r = 0; r < 16; ++r) ls += __builtin_amdgcn_exp2f(S[kb2][r] - m);
            l += ls;
            s_nxt2 = s_cur; s_cur = (s_cur == 2 * STG) ? 0 : s_cur + STG;
        }
        NSA_WAIT(0); NSA_BAR();
        }
        l += swap_other(l);
        const float inv_l = l > 0.f ? 1.0f / l : 0.f;
        f32x16 O[4];
        for (int rp = 0; rp < (ATT_DBL == 2 ? 2 : 1); ++rp) {
        const bool do_imp = (rp == (ATT_DBL == 2 ? 1 : 0));
#pragma unroll
        for (int db = 0; db < 4; ++db)
#pragma unroll
            for (int r = 0; r < 16; ++r) O[db][r] = 0.f;
        dma_k(kc, 256, L, wave, lane); dma_v(vc, 256, L + KIMG, wave, lane);
        if (ntc > 1) { dma_k(kc + (size_t)64 * 256, 256, L + STG, wave, lane); dma_v(vc + (size_t)64 * 256, 256, L + STG + KIMG, wave, lane); }
        int s_cur = 0, s_nxt2 = 2 * STG;
        for (int i = 0; i < ntc; ++i) {
            if (i + 1 < ntc) NSA_WAIT(4); else NSA_WAIT(0);
            NSA_BAR();
            if (i + 2 < ntc) { dma_k(kc + (size_t)(i + 2) * 64 * 256, 256, L + s_nxt2, wave, lane); dma_v(vc + (size_t)(i + 2) * 64 * 256, 256, L + s_nxt2 + KIMG, wave, lane); }
            const int nb = 64 * i; const int dbase = t - 31 - 16 * (nb + 4 * hf);
            f32x16 S[2];
            qk_tile(S, L + s_cur, qf, -sl2 * (float)dbase - m, sl2 * 16.f, lane);
            if (16 * (nb + 63) + 31 > t0) { asm volatile("" : "+v"(S[0]), "+v"(S[1])); mask_tile(S, dbase, 16, 0x7fffffffu); }
#pragma unroll
            for (int kb2 = 0; kb2 < 2; ++kb2)
#pragma unroll
                for (int r = 0; r < 16; ++r) S[kb2][r] = __builtin_amdgcn_exp2f(S[kb2][r]) * inv_l;
#pragma unroll
            for (int kb2 = 0; kb2 < 2; ++kb2)
#pragma unroll
                for (int i2 = 0; i2 < 4; ++i2) {
                    const float p3 = S[kb2][4 * i2 + 3];
                    float cm = 32.f * ((S[kb2][4 * i2] + S[kb2][4 * i2 + 1]) + S[kb2][4 * i2 + 2]) + 16.f * p3, cn = 16.f * p3;
                    cm += ror8(cm); cm += xor16(cm); cn += ror8(cn); cn += xor16(cn);
                    if (hh == 0 && do_imp) { const int j = ((nb + 32 * kb2) >> 2) + 2 * i2 + hf; NLAS float* ip = imp + (8 * wave + qi) * IMPS + j; ip[0] += cm; }
                    asm volatile("" ::: "memory");
                    if (hh == 0 && do_imp) { const int j = ((nb + 32 * kb2) >> 2) + 2 * i2 + hf; NLAS float* ip = imp + (8 * wave + qi) * IMPS + j; ip[1] += cn; }
                    asm volatile("" ::: "memory");
                }
            { bf16x8 pf[4]; pack_p(pf, S); pv_tile(O, pf, L + s_cur + KIMG, lane); }
            s_nxt2 = s_cur; s_cur = (s_cur == 2 * STG) ? 0 : s_cur + STG;
        }
        NSA_WAIT(0); NSA_BAR();
        }
        y_store(y32a + yprv, O, gp[0]);
        for (int rp = 0; rp < (ATT_DBL == 3 ? 2 : 1); ++rp) {
            unsigned m0 = 0u, m1 = 0u, m2 = 0u, m3 = 0u; const int q = tid >> 3, part = tid & 7;
            const int nf = cur >= 2 ? 3 : cur + 1;
#pragma unroll
            for (int f3 = 0; f3 < 3; ++f3) { const int bi = f3 == 0 ? 0 : f3 == 1 ? cur : (cur >= 1 ? cur - 1 : 0); const unsigned bit = 1u << (bi & 31); const int w = bi >> 5; m0 |= w == 0 ? bit : 0u; m1 |= w == 1 ? bit : 0u; m2 |= w == 2 ? bit : 0u; m3 |= w == 3 ? bit : 0u; }
            unsigned k[16];
#pragma unroll
            for (int i4 = 0; i4 < 4; ++i4) { const f32x4 raw = *(const NLAS f32x4*)(imp + q * IMPS + part * 16 + 4 * i4);
#pragma unroll
                for (int e = 0; e < 4; ++e) { const int j = part * 16 + 4 * i4 + e; const bool forced = (j == 0) || (j == cur) || (j == cur - 1);
                    k[4 * i4 + e] = (j <= cur && !forced) ? ((__float_as_uint(raw[e]) & 0xFFFFFF00u) | (unsigned)(255 - j)) : 0u; } }
            unsigned prev = 0xFFFFFFFFu;
            for (int r = nf; r < 16; ++r) {
                unsigned bk = 0u;
#pragma unroll
                for (int i = 0; i < 16; ++i) { const unsigned c = k[i] < prev ? k[i] : 0u; bk = c > bk ? c : bk; }
                { const unsigned o = (unsigned)__builtin_amdgcn_update_dpp(0, (int)bk, 0xB1, 0xF, 0xF, false); bk = o > bk ? o : bk; }
                { const unsigned o = (unsigned)__builtin_amdgcn_update_dpp(0, (int)bk, 0x4E, 0xF, 0xF, false); bk = o > bk ? o : bk; }
                { const unsigned o = (unsigned)__builtin_amdgcn_update_dpp(0, (int)bk, 0x141, 0xF, 0xF, false); bk = o > bk ? o : bk; }
                prev = bk;
                if (bk != 0u) { const int bi = 255 - (int)(bk & 0xFFu); const unsigned bit = 1u << (bi & 31); const int w = bi >> 5; m0 |= w == 0 ? bit : 0u; m1 |= w == 1 ? bit : 0u; m2 |= w == 2 ? bit : 0u; m3 |= w == 3 ? bit : 0u; }
            }
            if (part == 0) { selm[q * 4 + 0] = m0; selm[q * 4 + 1] = m1; selm[q * 4 + 2] = m2; selm[q * 4 + 3] = m3;
                atomicOr((unsigned*)(um + 0), m0); atomicOr((unsigned*)(um + 1), m1); atomicOr((unsigned*)(um + 2), m2); atomicOr((unsigned*)(um + 3), m3); }
        }
        __syncthreads();
        int nts;
        {
            const unsigned u0 = um[0], u1 = um[1], u2 = um[2], u3 = um[3];
            nts = __popc(u0) + __popc(u1) + __popc(u2) + __popc(u3);
            if (tid < 128) { const int w = tid >> 5, b = tid & 31; const unsigned uw = w == 0 ? u0 : w == 1 ? u1 : w == 2 ? u2 : u3;
                if ((uw >> b) & 1u) { int rank = __popc((uw >> b) >> 1); if (w < 3) rank += __popc(u3); if (w < 2) rank += __popc(u2); if (w < 1) rank += __popc(u1); tl[rank] = tid; } }
        }
        asm volatile("s_waitcnt vmcnt(0)" ::: "memory");
        __syncthreads();
        float lb;
        for (int rp = 0; rp < (ATT_DBL == 4 ? 2 : 1); ++rp)
        online_branch<false>(F, tid, L, qf, O, lb, kvb + (size_t)2 * T * 512 + g * 256, kvb + (size_t)3 * T * 512 + g * 256, tl, nts, t, sl2, cur, selm + (8 * wave + qi) * 4);
        y_store(y32b + yprv, O, lb > 0.f ? gp[1] / lb : 0.f);
        const int ntw = cur >= 8 ? 9 : cur + 1;
        if (tid < ntw) tl[tid] = cur - tid;
        asm volatile("s_waitcnt vmcnt(0)" ::: "memory");
        __syncthreads();
        for (int rp = 0; rp < (ATT_DBL == 5 ? 2 : 1); ++rp)
        online_branch<true>(F, tid, L, qf, O, lb, kvb + (size_t)4 * T * 512 + g * 256, kvb + (size_t)5 * T * 512 + g * 256, tl, ntw, t, sl2, cur, selm);
        { const float f = lb > 0.f ? gp[2] / lb : 0.f; const float* pa = y32a + yprv; const float* pb = y32b + yprv; bf16* po = ya + (size_t)t * YLD + head * 128 + 4 * hf;
#pragma unroll
          for (int db = 0; db < 4; ++db)
#pragma unroll
            for (int i = 0; i < 4; ++i) { const u32x2 aw = *(const u32x2*)(pa + (4 * db + i) * 128), bw = *(const u32x2*)(pb + (4 * db + i) * 128); const f32x4 a = {bflo(aw.x), bfhi(aw.x), bflo(aw.y), bfhi(aw.y)}, b = {bflo(bw.x), bfhi(bw.x), bflo(bw.y), bfhi(bw.y)};
                u32x2 w; w.x = pk2(a[0] + b[0] + O[db][4 * i] * f, a[1] + b[1] + O[db][4 * i + 1] * f); w.y = pk2(a[2] + b[2] + O[db][4 * i + 2] * f, a[3] + b[3] + O[db][4 * i + 3] * f);
                *(u32x2*)(po + 32 * db + 8 * i) = w; } }
    }
    __syncthreads();
}

#define XB_ROWCNT(pm) (3584 + 16 * (pm))
struct EpiResNorm {
    static constexpr bool PERM = true, AFTER_DRAIN = false, HAS_MID = false, USES_LDS = false;
    const bf16* xb; float* part; unsigned* bar; const float* fg; float* out;
    __device__ __forceinline__ void operator()(f32x4 (&acc)[2][2][4][2], const Unit& u, int wr, int wc, int fr, int fq) const {
        const int row0 = u.pm * 256 + wr * 64 + fr, col0 = u.pn * 256 + wc * 32 + 8 * fq;
#pragma unroll
        for (int ai = 0; ai < 2; ++ai)
#pragma unroll
            for (int m = 0; m < 4; ++m) { const int row = row0 + ai * 128 + m * 16; const size_t ro = (size_t)row * 2048 + col0; float ss = 0.f;
#pragma unroll
                for (int bj = 0; bj < 2; ++bj)
#pragma unroll
                    for (int n = 0; n < 2; ++n) { const size_t o = ro + bj * 128 + 4 * n; const u32x2 xw = *(const u32x2*)(xb + o);
                        f32x4 v = acc[ai][bj][m][n]; v[0] += bflo(xw.x); v[1] += bfhi(xw.x); v[2] += bflo(xw.y); v[3] += bfhi(xw.y);
                        ss += (v[0] * v[0] + v[1] * v[1]) + (v[2] * v[2] + v[3] * v[3]); acc[ai][bj][m][n] = v; }
                ss += lane_xor16(ss); ss += lane_xor32(ss);
                if (fq == 0) __hip_atomic_store(part + (size_t)row * 32 + u.pn * 4 + wc, ss, __ATOMIC_RELAXED, __HIP_MEMORY_SCOPE_AGENT); }
        asm volatile("s_waitcnt vmcnt(0)" ::: "memory");
        __syncthreads();
        if (threadIdx.x == 0) { unsigned* c = bar + XB_ROWCNT(u.pm); (void)xb_add(c, 1u); XB_SPIN(xb_ld(c) < 8u, bar); }
        __syncthreads();
        float rs[2][4];
#pragma unroll
        for (int ai = 0; ai < 2; ++ai)
#pragma unroll
            for (int m = 0; m < 4; ++m) { const int row = row0 + ai * 128 + m * 16; const unsigned long long* pp = (const unsigned long long*)(part + (size_t)row * 32 + fq * 8); float ss = 0.f;
#pragma unroll
                for (int i = 0; i < 4; ++i) { const unsigned long long w = __hip_atomic_load(pp + i, __ATOMIC_RELAXED, __HIP_MEMORY_SCOPE_AGENT); ss += __uint_as_float((unsigned)w) + __uint_as_float((unsigned)(w >> 32)); }
                rs[ai][m] = ss; }
#pragma unroll
        for (int ai = 0; ai < 2; ++ai)
#pragma unroll
            for (int m = 0; m < 4; ++m) { float ss = rs[ai][m]; ss += lane_xor16(ss); ss += lane_xor32(ss); rs[ai][m] = rsqrtf(ss * (1.0f / DM) + NORM_EPS); }
#pragma unroll
        for (int bj = 0; bj < 2; ++bj)
#pragma unroll
            for (int n = 0; n < 2; ++n) { const f32x4 g4 = *(const f32x4*)(fg + col0 + bj * 128 + 4 * n);
#pragma unroll
                for (int ai = 0; ai < 2; ++ai)
#pragma unroll
                    for (int m = 0; m < 4; ++m) { const int row = row0 + ai * 128 + m * 16; const float r = rs[ai][m]; const f32x4 v = acc[ai][bj][m][n];
                        f32x4 o; o[0] = v[0] * r * g4[0]; o[1] = v[1] * r * g4[1]; o[2] = v[2] * r * g4[2]; o[3] = v[3] * r * g4[3];
                        *(f32x4*)(out + (size_t)row * 2048 + col0 + bj * 128 + 4 * n) = o; } }
    }
};

__device__ __forceinline__ void p8_final(const Frame& F, const Args& A) {
    const int gw = F.bid * NWAVES + F.wave, NGW = F.G * NWAVES;
    const float* part = (const float*)(F.ws + WS_P3); const float* fg = A.in[21]; const bf16* x3 = (const bf16*)(F.ws + WS_H);
    f32x4 gq[8];
#pragma unroll
    for (int j = 0; j < 4; ++j) { gq[2 * j] = ((const f32x4*)fg)[(F.lane + 64 * j) * 2]; gq[2 * j + 1] = ((const f32x4*)fg)[(F.lane + 64 * j) * 2 + 1]; }
    for (int m0 = gw; m0 < T; m0 += 2 * NGW) {
        const int m1 = m0 + NGW; const bool has1 = m1 < T; const int m1c = has1 ? m1 : m0;
        const float s0 = F.lane < 32 ? part[(size_t)m0 * 32 + F.lane] : 0.f, s1 = F.lane < 32 ? part[(size_t)m1c * 32 + F.lane] : 0.f;
        u32x4 w0[4], w1[4];
#pragma unroll
        for (int j = 0; j < 4; ++j) { w0[j] = ((const u32x4*)(x3 + (size_t)m0 * DM))[F.lane + 64 * j]; w1[j] = ((const u32x4*)(x3 + (size_t)m1c * DM))[F.lane + 64 * j]; }
        const float r0 = rsqrtf(wave_sum(s0) * (1.0f / DM) + NORM_EPS), r1 = rsqrtf(wave_sum(s1) * (1.0f / DM) + NORM_EPS);
#pragma unroll
        for (int rr = 0; rr < 2; ++rr) { if (rr == 1 && !has1) break; const float r = rr ? r1 : r0; f32x4* orow = (f32x4*)(A.out + (size_t)(rr ? m1 : m0) * DM);
#pragma unroll
            for (int j = 0; j < 4; ++j) { const u32x4 w = rr ? w1[j] : w0[j]; const int c4 = (F.lane + 64 * j) * 2; const f32x4 g0 = gq[2 * j], g1 = gq[2 * j + 1];
                f32x4 o0, o1; o0[0] = bflo(w.x) * r * g0[0]; o0[1] = bfhi(w.x) * r * g0[1]; o0[2] = bflo(w.y) * r * g0[2]; o0[3] = bfhi(w.y) * r * g0[3];
                o1[0] = bflo(w.z) * r * g1[0]; o1[1] = bfhi(w.z) * r * g1[1]; o1[2] = bflo(w.w) * r * g1[2]; o1[3] = bfhi(w.w) * r * g1[3];
                orow[c4] = o0; orow[c4 + 1] = o1; } }
    }
}

constexpr int NPHASE = 10;
__global__ void __launch_bounds__(NTHR, 2) mega_fwd(Args args) {
    extern __shared__ __attribute__((aligned(16))) unsigned char lds[];
    cg::grid_group grid = cg::this_grid();
    Frame F; F.lds = lds; F.tid = threadIdx.x; F.lane = F.tid & 63; F.wave = __builtin_amdgcn_readfirstlane(F.tid >> 6); F.G = gridDim.x; F.bid = blockIdx.x; F.ws = args.ws;
    PG8_LAS unsigned char* lds3 = (PG8_LAS unsigned char*)lds;
    const int lo = args.ph_lo, hi = args.ph_hi;
    volatile __attribute__((address_space(3))) unsigned* xst = (volatile __attribute__((address_space(3))) unsigned*)(lds3 + LDS_BYTES - 16);
    if (F.tid == 0) { xst[0] = 0u; xst[1] = 0u; }
    __syncthreads();
    if (MK_ONE_LAUNCH && GSYNC_SEAM == 0 && F.bid == 0) { unsigned* bw = (unsigned*)(args.ws + WS_BAR); for (int e = F.tid; e < 4096; e += NTHR) bw[e] = 0u; }
    XcdBarrier xbar; xbar.bar = (unsigned*)(args.ws + WS_BAR); xbar.x = 0; xbar.st = xst;
    if (MK_ONE_LAUNCH && GSYNC_SEAM != 0) xbar = xcd_barrier_post((unsigned*)(args.ws + WS_BAR), xst);
#define IN(k) (lo <= (k) && (k) < hi)
#define SEAM(k) do { if (IN(k) && IN((k) + 1)) { if ((k) == GSYNC_SEAM) grid.sync(); else xcd_barrier(xbar); } } while (0)
    unsigned char* ws = args.ws;
#define PH0 { p0_prologue(F, args); if (!FILL_FFN_IN_P1) convert_wffn(F, args, F.bid, F.G); if (!FILL_DOWN_IN_P6) convert_wdown(F, args, F.bid, F.G); }
#define PH1 { pg8::Gemm g{(const bf16*)(ws + WS_H), (const bf16*)(ws + WS_WIN), T, NP0M, DM, DM}; pg8::StaticOrder S; S.init(T, NP0M, F.G, F.bid); S.wgm = WGM_BIG; \
        Epi0 E{ws, 0}; pg8::gemm_phase<Epi0, pg8::StaticOrder, true, true>(lds3, g, S, E); }
#define PH2 { const int gt = F.G >= 256 ? 96 : F.G; \
        if (F.bid < gt) { pg8::Gemm g{(const bf16*)(ws + WS_H), (const bf16*)(ws + WS_WIN) + (size_t)NP0M * DM, T, NP0 - NP0M, DM, DM}; pg8::StaticOrder S; S.init(T, NP0 - NP0M, gt, F.bid); \
            Epi0 E{ws, NP0M / 256}; pg8::gemm_phase<Epi0, pg8::StaticOrder, true, true>(lds3, g, S, E); } \
        __syncthreads(); p2_phase(F, args, F.G >= 256 ? 96 : 0); }
#define PH3 { p3_attn(F, args); \
        const int vcu3 = (F.G % 8 == 0) ? (F.bid % 8) * (F.G / 8) + F.bid / 8 : F.bid;     \
        int it = SGU_EARLY + F.bid, step = F.G, end = 512; if (F.G >= 256) { int c_; sgu_filler(vcu3 < 256 ? 127 - (vcu3 >> 1) : 127, vcu3 & 1, it, c_); step = 1; end = it + c_; } \
        for (; it < end; it += step) p2::sgu_item(F, args, it); }
#define PH4 { pg8::Gemm g{(const bf16*)(ws + WS_YA), (const bf16*)(ws + WS_WPA), T, DM, 1024, DM}; pg8::MixOrder S; S.init(T, DM, F.G, F.bid); S.wgm = WGM_MIX; \
        EpiMix E{(const bf16*)(ws + WS_GA), (const bf16*)(ws + WS_GB), (bf16*)(ws + WS_MIXED)}; pg8::gemm_phase<EpiMix, pg8::MixOrder, true, true>(lds3, g, S, E); }
#define PH5 { pg8::Gemm g{(const bf16*)(ws + WS_MIXED), (const bf16*)(ws + WS_WOUT), T, DM, DM, DM}; pg8::StaticOrder S; S.init(T, DM, F.G, F.bid); S.wgm = WGM_MIX; \
        EpiRes E{(const float*)(ws + WS_RINV), (bf16*)(ws + WS_H), (float*)(ws + WS_P2)}; pg8::gemm_phase<EpiRes, pg8::StaticOrder, true, true>(lds3, g, S, E); }
#define PH6 { pg8::Gemm g{(const bf16*)(ws + WS_H), (const bf16*)(ws + WS_WFFN), T, 2 * DFF, DM, DM}; pg8::FfnOrder S; S.init_tiles(34, 43, F.G, F.bid); S.wgm = WGM_BIG; \
        EpiFfnConv E{(const float*)(ws + WS_P2), (const u32x2*)(ws + WS_CONVP), (bf16*)(ws + WS_G)}; pg8::gemm_phase<EpiFfnConv, pg8::FfnOrder, true, true>(lds3, g, S, E); \
        if (FILL_DOWN_IN_P6) { const int rem = S.nwg % F.G; if (rem != 0 && F.bid >= rem) convert_wdown(F, args, F.bid - rem, F.G - rem); else if (rem == 0) convert_wdown(F, args, F.bid, F.G); } }
#define PH7 { pg8::Gemm g{(const bf16*)(ws + WS_G), (const bf16*)(ws + WS_WDOWN), T, DM, DFF, 64, (size_t)T * 128, (size_t)DM * 128};     pg8::StaticOrder S; S.init(T, DM, F.G, F.bid); S.wgm = 4; \
        if (FUSE78) { EpiResNorm E{(const bf16*)(ws + WS_H), (float*)(ws + WS_P3), (unsigned*)(ws + WS_BAR), args.in[21], args.out}; pg8::gemm_phase<EpiResNorm, pg8::StaticOrder, true, true>(lds3, g, S, E); } \
        else { EpiResB E{(bf16*)(ws + WS_H), (float*)(ws + WS_P3)}; pg8::gemm_phase<EpiResB, pg8::StaticOrder, true, true>(lds3, g, S, E); } }
#define PH8 { p8_final(F, args); }
    if (IN(0)) PH0
#if DBL_PHASE == 0
    grid.sync(); PH0
#endif
    SEAM(0);
    if (MK_ONE_LAUNCH && GSYNC_SEAM == 0) xbar = xcd_barrier_post((unsigned*)(args.ws + WS_BAR), xst);
    if (IN(1)) PH1
#if DBL_PHASE == 1
    grid.sync(); PH1
#endif
    SEAM(1);
    if (IN(2)) PH2
#if DBL_PHASE == 2
    grid.sync(); PH2
#endif
    SEAM(2);
    if (IN(3)) PH3
#if DBL_PHASE == 3
    grid.sync(); PH3
#endif
    SEAM(3);
    if (IN(4)) PH4
#if DBL_PHASE == 4
    grid.sync(); PH4
#endif
    SEAM(4);
    if (IN(5)) PH5
#if DBL_PHASE == 5
    grid.sync(); PH5
#endif
    SEAM(5);
    if (IN(6)) PH6
#if DBL_PHASE == 6
    grid.sync(); PH6
#endif
    SEAM(6);
    const bool FUSE78 = MK_ONE_LAUNCH && F.G >= 256;
    if (IN(7)) PH7
    if (!FUSE78) { SEAM(7);
    if (IN(8)) PH8 }
#if DBL_PHASE == 200
    xcd_barrier(xbar);
    PH0 xcd_barrier(xbar); PH1 xcd_barrier(xbar); PH2 xcd_barrier(xbar); PH3 xcd_barrier(xbar); PH4 xcd_barrier(xbar); PH5 xcd_barrier(xbar); PH6 xcd_barrier(xbar); PH7 xcd_barrier(xbar); PH8
#endif
    if (DBL_PHASE == 100) { for (int i = 0; i < 10; ++i) grid.sync(); }
    if (DBL_PHASE == 101) { for (int i = 0; i < 10; ++i) xcd_barrier(xbar); }
#undef IN
#undef SEAM
}

extern "C" void kernel_launch(void* const* d_in, const int* in_sizes, int n_in, void* d_out, int out_size, void* d_ws, size_t ws_size, hipStream_t stream) {
    static int grid = 0;
    if (grid == 0) {
        if (n_in != 22 || in_sizes[0] != T * DM || out_size != T * DM || ws_size < WS_END) {
            fprintf(stderr, "kernel_launch: unexpected problem (n_in %d, in0 %d, out %d, ws %zu, need %zu)\n", n_in, n_in > 0 ? in_sizes[0] : -1, out_size, ws_size, (size_t)WS_END); grid = -1; return; }
        int dev = 0, cus = 0, per_cu = 0;
        hipGetDevice(&dev); hipDeviceGetAttribute(&cus, hipDeviceAttributeMultiprocessorCount, dev);
        hipFuncSetAttribute((const void*)mega_fwd, hipFuncAttributeMaxDynamicSharedMemorySize, LDS_BYTES);
        hipOccupancyMaxActiveBlocksPerMultiprocessor(&per_cu, (const void*)mega_fwd, NTHR, LDS_BYTES);
        (void)hipGetLastError();
        if (per_cu < 1) { fprintf(stderr, "kernel_launch: occupancy query says %d blocks per CU\n", per_cu); grid = -1; return; }
        grid = cus;
    }
    if (grid < 0) return;
    if (MK_ONE_LAUNCH && GSYNC_SEAM != 0) (void)hipMemsetAsync((char*)d_ws + WS_BAR, 0, 16384, stream);
    Args a{};
    for (int i = 0; i < 22; ++i) a.in[i] = (const float*)d_in[i];
    a.out = (float*)d_out; a.ws = (unsigned char*)d_ws;
#if MK_ONE_LAUNCH
    a.ph_lo = 0; a.ph_hi = NPHASE;
    void* kargs[] = {&a};
    hipError_t e = hipLaunchCooperativeKernel((const void*)mega_fwd, dim3(grid), dim3(NTHR), kargs, LDS_BYTES, stream);
    if (e != hipSuccess) fprintf(stderr, "cooperative launch failed: %s (grid %d)\n", hipGetErrorString(e), grid);
#else
    for (int p = 0; p <= 8; ++p) {
        a.ph_lo = p; a.ph_hi = p + 1;
        hipLaunchKernelGGL(mega_fwd, dim3(grid), dim3(NTHR), LDS_BYTES, stream, a);
    }
#endif
}
```
